# Optimizing an MI355X kernel written in HIP

```python
import jax, jax.numpy as jnp
from jax import lax
import numpy as np

D_MODEL = 2048
BATCH = 2
SEQ = 8192
DEPTH = 4

CHUNK = 64
Q_BLOCK = 128
SB_HEADS = 8
SB_HEAD_DIM = 128
SB_WIDTH = SB_HEADS * SB_HEAD_DIM
SGU_GROUPS = 8
SGU_GROUP_DIM = 128
SGU_WIDTH = SGU_GROUPS * SGU_GROUP_DIM
SGU_LEN = 128
D_FF = 4 * D_MODEL
IN_COLS = 3 * SB_WIDTH + 2 * SGU_WIDTH + 2 * D_MODEL
EPS = 1e-6

kernel_name = "hybrid_stickbreak_sgu_block"


def rms_norm(x, g):
    xf = x.astype(jnp.float32)
    y = xf * lax.rsqrt(jnp.mean(xf * xf, axis=-1, keepdims=True) + EPS)
    return (y * g.astype(jnp.float32)).astype(x.dtype)


def layer_norm(x, g, b):
    xf = x.astype(jnp.float32)
    mu = jnp.mean(xf, axis=-1, keepdims=True)
    xc = xf - mu
    y = xc * lax.rsqrt(jnp.mean(xc * xc, axis=-1, keepdims=True) + EPS)
    return (y * g.astype(jnp.float32) + b.astype(jnp.float32)).astype(x.dtype)


def stick_breaking_attention(q, k, v):
    seq = q.shape[2]
    scale = SB_HEAD_DIM ** -0.5
    outs = []
    for blk in range(seq // Q_BLOCK):
        q0 = blk * Q_BLOCK
        kend = q0 + Q_BLOCK
        qb = q[:, :, q0:kend].astype(jnp.float32)
        kb = k[:, :, :kend].astype(jnp.float32)
        vb = v[:, :, :kend]
        z = jnp.einsum('bhtd,bhsd->bhts', qb, kb) * scale
        t_idx = q0 + jnp.arange(Q_BLOCK)[:, None]
        s_idx = jnp.arange(kend)[None, :]
        past = s_idx < t_idx
        log_keep = jnp.where(past, jax.nn.log_sigmoid(-z), 0.0)
        tail = lax.cumsum(log_keep, axis=3, reverse=True) - log_keep
        log_a = jax.nn.log_sigmoid(z) + tail
        a = jnp.where(past, jnp.exp(log_a), 0.0)
        outs.append(jnp.einsum('bhts,bhsd->bhtd', a.astype(v.dtype), vb))
    return jnp.concatenate(outs, axis=2)


def spatial_gating(u, v, ln_g, ln_b, w_s, b_s):
    bsz, seq, _ = v.shape
    v = layer_norm(v, ln_g, ln_b)
    vc = v.reshape(bsz, seq // SGU_LEN, SGU_LEN, SGU_GROUPS, SGU_GROUP_DIM)
    pos = jnp.arange(SGU_LEN)
    mask = (pos[None, :] // CHUNK) <= (pos[:, None] // CHUNK)
    w = jnp.where(mask[None], w_s, jnp.zeros_like(w_s))
    mixed = jnp.einsum('gij,bcjgd->bcigd', w, vc) + b_s.T[:, :, None]
    return u * mixed.reshape(bsz, seq, SGU_WIDTH)


def setup_inputs(seed: int = 0) -> dict:
    key = jax.random.key(seed)
    ks = jax.random.split(key, 16)
    f32 = jnp.float32
    nrm = lambda k, shape, s: jax.random.normal(k, shape, f32) * s
    return {
        "x": nrm(ks[0], (BATCH, SEQ, D_MODEL), 1.0),
        "g_mix": 1.0 + nrm(ks[1], (DEPTH, D_MODEL), 0.05),
        "w_in": nrm(ks[2], (DEPTH, D_MODEL, IN_COLS), D_MODEL ** -0.5),
        "g_q": 1.0 + nrm(ks[3], (DEPTH, SB_HEADS, SB_HEAD_DIM), 0.05),
        "g_k": 1.0 + nrm(ks[4], (DEPTH, SB_HEADS, SB_HEAD_DIM), 0.05),
        "sgu_ln_g": 1.0 + nrm(ks[5], (DEPTH, SGU_WIDTH), 0.05),
        "sgu_ln_b": nrm(ks[6], (DEPTH, SGU_WIDTH), 0.02),
        "w_spatial": nrm(ks[7], (DEPTH, SGU_GROUPS, SGU_LEN, SGU_LEN), SGU_LEN ** -0.5),
        "b_spatial": 1.0 + nrm(ks[8], (DEPTH, SGU_GROUPS, SGU_LEN), 0.05),
        "w_oa": nrm(ks[9], (DEPTH, SB_WIDTH, D_MODEL), SB_WIDTH ** -0.5),
        "w_ob": nrm(ks[10], (DEPTH, SGU_WIDTH, D_MODEL), SGU_WIDTH ** -0.5),
        "w_out": nrm(ks[11], (DEPTH, D_MODEL, D_MODEL), D_MODEL ** -0.5),
        "g_ff": 1.0 + nrm(ks[12], (DEPTH, D_MODEL), 0.05),
        "w_ff1": nrm(ks[13], (DEPTH, D_MODEL, D_FF), D_MODEL ** -0.5),
        "w_ff2": nrm(ks[14], (DEPTH, D_FF, D_MODEL), D_FF ** -0.5),
    }


def reference(x, g_mix, w_in, g_q, g_k, sgu_ln_g, sgu_ln_b, w_spatial, b_spatial,
              w_oa, w_ob, w_out, g_ff, w_ff1, w_ff2):
    bsz, seq, _ = x.shape
    splits = [SB_WIDTH, 2 * SB_WIDTH, 3 * SB_WIDTH,
              3 * SB_WIDTH + SGU_WIDTH, 3 * SB_WIDTH + 2 * SGU_WIDTH,
              3 * SB_WIDTH + 2 * SGU_WIDTH + D_MODEL]
    for l in range(DEPTH):
        h = rms_norm(x, g_mix[l])
        proj = h @ w_in[l]
        q, k, v_sb, u, v_sg, gate_a, gate_b = jnp.split(proj, splits, axis=-1)

        q = rms_norm(q.reshape(bsz, seq, SB_HEADS, SB_HEAD_DIM), g_q[l])
        k = rms_norm(k.reshape(bsz, seq, SB_HEADS, SB_HEAD_DIM), g_k[l])
        v_sb = v_sb.reshape(bsz, seq, SB_HEADS, SB_HEAD_DIM)
        o = stick_breaking_attention(q.transpose(0, 2, 1, 3), k.transpose(0, 2, 1, 3),
                                     v_sb.transpose(0, 2, 1, 3))
        y_a = o.transpose(0, 2, 1, 3).reshape(bsz, seq, SB_WIDTH) @ w_oa[l]

        u = jax.nn.gelu(u, approximate=False)
        v_sg = jax.nn.gelu(v_sg, approximate=False)
        s = spatial_gating(u, v_sg, sgu_ln_g[l], sgu_ln_b[l], w_spatial[l], b_spatial[l])
        y_b = s @ w_ob[l]

        merged = jax.nn.sigmoid(gate_a) * y_a + jax.nn.sigmoid(gate_b) * y_b
        x = x + merged @ w_out[l]

        h2 = rms_norm(x, g_ff[l])
        x = x + jnp.square(jax.nn.relu(h2 @ w_ff1[l])) @ w_ff2[l]
    return x
```

```cpp
#include <hip/hip_runtime.h>
#include <cstdio>
#include <cstdint>
#ifndef EPI_DRAIN
#define EPI_DRAIN 0
#endif
#ifndef GP_SP2
#define GP_SP2 true
#endif
#ifndef GP_ALIGN
#define GP_ALIGN true
#endif
#ifndef GEMM_ROT
#define GEMM_ROT 4
#endif
#ifndef FFN_SPLIT
#define FFN_SPLIT 1
#endif
#ifndef EPI_NT
#define EPI_NT 0
#endif
#ifndef I8_INPROJ
#define I8_INPROJ 1
#endif
#ifndef I8_FF1
#define I8_FF1 1
#endif
static_assert(!I8_FF1 || I8_INPROJ, "I8_FF1 needs I8_INPROJ");
#ifndef FFN_LOCAL
#define FFN_LOCAL 1
#endif
#ifndef MIX_LOCAL
#define MIX_LOCAL 1
#endif
#ifndef GATES8
#define GATES8 1
#endif
#ifndef I8_OUT
#define I8_OUT 0
#endif
static_assert(!I8_OUT || I8_INPROJ, "I8_OUT needs I8_INPROJ");
static_assert(!GATES8 || (I8_INPROJ && I8_FF1), "GATES8 lives in the bf16 FFN-up copy's region and is written by the int8 in-projection epilogue only");
namespace pg8 {
#define PG8_LAS __attribute__((address_space(3)))
typedef unsigned short bf16_t;
typedef short bf16x8 __attribute__((ext_vector_type(8)));
typedef float f32x4 __attribute__((ext_vector_type(4)));
typedef unsigned u32x4 __attribute__((ext_vector_type(4)));
typedef int i32x4_t __attribute__((ext_vector_type(4)));
constexpr int BM = 256, BK = 64, HALF = 128, HTB = HALF * BK * 2  , STAGE_BYTES = 8 * HTB, NXCD = 8, WGM = 8;

__host__ __device__ __forceinline__ int lds_byte(int r, int c) { const int st = (r >> 4) * 2 + (c >> 5), rr = r & 15, cc = c & 31, ob = rr * 64 + cc * 2; return st * 1024 + (ob ^ (((ob >> 9) & 1) << 5)); }
__host__ __device__ __forceinline__ void stage_rc(int b, int& R, int& C) { const int st = b / 1024, sb = b % 1024, swz = sb ^ (((sb >> 9) & 1) << 5); R = (st >> 1) * 16 + swz / 64; C = (st & 1) * 32 + (swz % 64) / 2; }
__host__ __device__ __forceinline__ int perm32(int rho) { const int n = rho >> 4, i = rho & 15; return 8 * (i >> 2) + 4 * n + (i & 3); }

struct Unit { int pm, pn, ord; };
struct Gemm { const bf16_t* A; const bf16_t* Bt; int M, N, K, krot; };

struct StaticOrder {
    int nM, nN, nwg, G, c, rot;
    __host__ __device__ void init(int M, int N, int G_, int c_) { nM = M / BM; nN = N / BM; nwg = nM * nN; G = G_; c = c_; rot = (GEMM_ROT && nwg % NXCD == 0 && (nwg / NXCD) % (WGM * nN) == 0 && nM % WGM == 0 && G_ % NXCD == 0) ? (GEMM_ROT * (c_ % NXCD)) % nN : 0; }
    __host__ __device__ bool next(int i, Unit& u) const {
        const long L = (long)i * G + c; if (L >= nwg) return false;
        int wgid = (int)L; { const int q = nwg / NXCD, r = nwg % NXCD, xcd = wgid % NXCD, off = wgid / NXCD; wgid = (xcd < r ? xcd * (q + 1) : r * (q + 1) + (xcd - r) * q) + off; }
        const int nig = WGM * nN, gid = wgid / nig, fm = gid * WGM, gsz = (nM - fm) < WGM ? (nM - fm) : WGM;
        u.pm = fm + ((wgid % nig) % gsz); u.pn = (wgid % nig) / gsz + rot; if (u.pn >= nN) u.pn -= nN; return true;
    }
    __device__ __forceinline__ void a_ready(const Unit&) const {}
    __device__ __forceinline__ void done(const Unit&) const {}
};

__device__ __forceinline__ unsigned cvt_pk_bf16(float lo, float hi) { typedef __bf16 bf2_t __attribute__((ext_vector_type(2))); typedef float f2_t __attribute__((ext_vector_type(2))); const f2_t v = {lo, hi}; return __builtin_bit_cast(unsigned, __builtin_convertvector(v, bf2_t)); }
typedef float f32x2 __attribute__((ext_vector_type(2)));
__device__ __forceinline__ f32x2 gelu_pk(f32x2 v) {
    const f32x2 av = __builtin_elementwise_abs(v), d = av * 0.2316418882f + 1.0f;
    f32x2 t; t.x = __builtin_amdgcn_rcpf(d.x); t.y = __builtin_amdgcn_rcpf(d.y);
    f32x2 q = t * 0.5307027145f + (-0.7265760135f); q = q * t + 0.7107068705f; q = q * t + (-0.142248368f); q = q * t + 0.127414796f; q = q * t;
    const f32x2 s = (v * v) * (-0.72134752044f);
    f32x2 e; e.x = __builtin_amdgcn_exp2f(s.x); e.y = __builtin_amdgcn_exp2f(s.y);
    const f32x2 m = v * (q * e), r = v - m;
    f32x2 o; o.x = v.x < 0.f ? m.x : r.x; o.y = v.y < 0.f ? m.y : r.y; return o;
}

__device__ __forceinline__ float bf_lo(unsigned w) { return __uint_as_float(w << 16); }
__device__ __forceinline__ float bf_hi(unsigned w) { return __uint_as_float(w & 0xffff0000u); }
__device__ __forceinline__ float sigmoid_f(float v) { return __builtin_amdgcn_rcpf(1.0f + __builtin_amdgcn_exp2f(v * -1.4426950409f)); }

struct RsPre { unsigned long long q[2][4]; };
__device__ __forceinline__ void rs_prefetch(const unsigned long long* rowsq, int row0, RsPre& p) {
#pragma unroll
    for (int ai = 0; ai < 2; ++ai)
#pragma unroll
        for (int m = 0; m < 4; ++m) p.q[ai][m] = rowsq[row0 + ai * HALF + m * 16];
}
__device__ __forceinline__ void rs_from(const RsPre& p, float (&rs)[2][4]) {
#pragma unroll
    for (int ai = 0; ai < 2; ++ai)
#pragma unroll
        for (int m = 0; m < 4; ++m) rs[ai][m] = __builtin_amdgcn_rsqf((float)p.q[ai][m] * (1.0f / (2048.0f * 16777216.0f)) + 1e-6f);
}
struct NoPre {};
__device__ __forceinline__ float rs_of(unsigned long long q) { return __builtin_amdgcn_rsqf((float)q * (1.0f / (2048.0f * 16777216.0f)) + 1e-6f); }
template <bool TAB> __device__ __forceinline__ void rs_get(const unsigned long long* rowsq, const PG8_LAS float* tab, int pm, int r0, float (&rs)[2][4]) {
    if constexpr (TAB) {
#pragma unroll
        for (int ai = 0; ai < 2; ++ai)
#pragma unroll
            for (int m = 0; m < 4; ++m) rs[ai][m] = tab[r0 + ai * HALF + m * 16]; }
    else { RsPre p; rs_prefetch(rowsq, pm * BM + r0, p); rs_from(p, rs); }
}
#if EPI_NT
#define EPI_STORE16(p, v) __builtin_nontemporal_store((v), (u32x4*)(p))
#else
#define EPI_STORE16(p, v) (*(u32x4*)(p) = (v))
#endif
template <int KIND, bool I8 = false> __device__ __forceinline__ void act_store_bf16(const f32x4 (&acc)[2][2][4][2], const float (&rs)[2][4], bf16_t* base  , int ldc, const PG8_LAS float* swp = nullptr) {
    f32x4 sw0[2], sw1[2];
    if constexpr (I8) {
#pragma unroll
        for (int bj = 0; bj < 2; ++bj) { sw0[bj] = *(const PG8_LAS f32x4*)(swp + bj * HALF); sw1[bj] = *(const PG8_LAS f32x4*)(swp + bj * HALF + 4); } }
#pragma unroll
    for (int ai = 0; ai < 2; ++ai)
#pragma unroll
        for (int m = 0; m < 4; ++m) { bf16_t* rowp = base + (size_t)(ai * HALF + m * 16) * ldc; const float r = rs[ai][m];
#pragma unroll
            for (int bj = 0; bj < 2; ++bj) { f32x4 v0, v1;
                if constexpr (I8) { const i32x4_t a0 = __builtin_bit_cast(i32x4_t, acc[ai][bj][m][0]), a1 = __builtin_bit_cast(i32x4_t, acc[ai][bj][m][1]);
                    v0 = (f32x4){(float)a0[0], (float)a0[1], (float)a0[2], (float)a0[3]} * sw0[bj] * r; v1 = (f32x4){(float)a1[0], (float)a1[1], (float)a1[2], (float)a1[3]} * sw1[bj] * r; }
                else { v0 = acc[ai][bj][m][0] * r; v1 = acc[ai][bj][m][1] * r; }
                if (KIND == 1) { f32x2 a = gelu_pk((f32x2){v0[0], v0[1]}), b = gelu_pk((f32x2){v0[2], v0[3]}), c = gelu_pk((f32x2){v1[0], v1[1]}), d = gelu_pk((f32x2){v1[2], v1[3]});
                    v0 = (f32x4){a.x, a.y, b.x, b.y}; v1 = (f32x4){c.x, c.y, d.x, d.y}; }
                if (KIND == 2) {
#pragma unroll
                    for (int j = 0; j < 4; ++j) { v0[j] = sigmoid_f(v0[j]); v1[j] = sigmoid_f(v1[j]); } }
                if (KIND == 3) {
#pragma unroll
                    for (int j = 0; j < 4; ++j) { const float a = fmaxf(v0[j], 0.f), b = fmaxf(v1[j], 0.f); v0[j] = a * a; v1[j] = b * b; } }
                u32x4 w; w.x = cvt_pk_bf16(v0[0], v0[1]); w.y = cvt_pk_bf16(v0[2], v0[3]); w.z = cvt_pk_bf16(v1[0], v1[1]); w.w = cvt_pk_bf16(v1[2], v1[3]);
                EPI_STORE16(rowp + bj * HALF, w); } }
}
template <bool I8> __device__ __forceinline__ void gate_store_u8(const f32x4 (&acc)[2][2][4][2], const float (&rs)[2][4], unsigned char* dst  , const PG8_LAS float* swp) {
    f32x4 sw0[2], sw1[2];
    if constexpr (I8) {
#pragma unroll
        for (int bj = 0; bj < 2; ++bj) { sw0[bj] = *(const PG8_LAS f32x4*)(swp + bj * HALF); sw1[bj] = *(const PG8_LAS f32x4*)(swp + bj * HALF + 4); } }
#pragma unroll
    for (int ai = 0; ai < 2; ++ai)
#pragma unroll
        for (int bj = 0; bj < 2; ++bj)
#pragma unroll
            for (int mh = 0; mh < 2; ++mh) { u32x4 w;
#pragma unroll
                for (int mm = 0; mm < 2; ++mm) { const int m = 2 * mh + mm; const float r = rs[ai][m]; f32x4 v0, v1;
                    if constexpr (I8) { const i32x4_t a0 = __builtin_bit_cast(i32x4_t, acc[ai][bj][m][0]), a1 = __builtin_bit_cast(i32x4_t, acc[ai][bj][m][1]);
                        v0 = (f32x4){(float)a0[0], (float)a0[1], (float)a0[2], (float)a0[3]} * sw0[bj] * r; v1 = (f32x4){(float)a1[0], (float)a1[1], (float)a1[2], (float)a1[3]} * sw1[bj] * r; }
                    else { v0 = acc[ai][bj][m][0] * r; v1 = acc[ai][bj][m][1] * r; }
                    unsigned q[8];
#pragma unroll
                    for (int j = 0; j < 4; ++j) { q[j] = (unsigned)__builtin_rintf(sigmoid_f(v0[j]) * 255.0f); q[4 + j] = (unsigned)__builtin_rintf(sigmoid_f(v1[j]) * 255.0f); }
                    const unsigned lo = q[0] | (q[1] << 8) | (q[2] << 16) | (q[3] << 24), hi = q[4] | (q[5] << 8) | (q[6] << 16) | (q[7] << 24);
                    if (mm == 0) { w.x = lo; w.y = hi; } else { w.z = lo; w.w = hi; } }
                EPI_STORE16(dst + (ai * 4 + bj * 2 + mh) * 1024, w); }
}
struct NoSide { struct State {}; __device__ __forceinline__ void begin(int, int, State&) const {} __device__ __forceinline__ void end(int, State&) const {} };
template <bool TAB, class Side = NoSide, bool I8 = false> struct EpiIn {
    static constexpr bool PERM = true, AFTER_DRAIN = false, CHAIN = false;
    bf16_t* O; const unsigned long long* rowsq; int ldc; const PG8_LAS float* rs_tab; int pm_tab; Side side; int pn_off; const PG8_LAS float* sw; unsigned char* g8;
    typedef NoPre Pre;
    __device__ __forceinline__ void prefetch(const Unit&, int, int, int, int, Pre&) const {}
    __device__ __forceinline__ void operator()(const f32x4 (&acc)[2][2][4][2], const Unit& u, int wr, int wc, int fr, int fq, const Pre&) const {
        const int pn = u.pn + pn_off; const int row0 = u.pm * BM + wr * 64 + fr, col0 = pn * BM + wc * 32 + 8 * fq;
        typename Side::State sst; side.begin(u.ord, fr + 16 * fq, sst);
        float rs[2][4]; rs_get<TAB>(rowsq, rs_tab, u.pm, wr * 64 + fr, rs);
        bf16_t* base = O + (size_t)row0 * ldc + col0;
        const PG8_LAS float* swp = I8 ? sw + u.ord * 256 + wc * 32 + 8 * fq : nullptr;
        if (pn < 12) act_store_bf16<0, I8>(acc, rs, base, ldc, swp); else if (pn < 20) act_store_bf16<1, I8>(acc, rs, base, ldc, swp);
#if GATES8
        else gate_store_u8<I8>(acc, rs, g8 + ((size_t)((pn >= 28 ? 512 : 0) + u.pm * 8 + (pn >= 28 ? pn - 28 : pn - 20)) << 16) + (wr * 4 + wc) * 8192 + (fr + 16 * fq) * 16, swp);
#else
        else act_store_bf16<2, I8>(acc, rs, base, ldc, swp);
#endif
        side.end(fr + 16 * fq, sst);
    }
};
template <bool TAB, class Side = NoSide, bool I8 = false> struct EpiFF1 {
    static constexpr bool PERM = true, AFTER_DRAIN = false, CHAIN = false;
    bf16_t* O; const unsigned long long* rowsq; int ldc; const PG8_LAS float* rs_tab; int pm_tab; Side side; const PG8_LAS float* sw;
    typedef NoPre Pre;
    __device__ __forceinline__ void prefetch(const Unit&, int, int, int, int, Pre&) const {}
    __device__ __forceinline__ void operator()(const f32x4 (&acc)[2][2][4][2], const Unit& u, int wr, int wc, int fr, int fq, const Pre&) const {
        const int row0 = u.pm * BM + wr * 64 + fr, col0 = u.pn * BM + wc * 32 + 8 * fq;
        typename Side::State sst; side.begin(u.ord, fr + 16 * fq, sst);
        float rs[2][4]; rs_get<TAB>(rowsq, rs_tab, u.pm, wr * 64 + fr, rs);
        act_store_bf16<3, I8>(acc, rs, O + (size_t)row0 * ldc + col0, ldc, I8 ? sw + u.ord * 256 + wc * 32 + 8 * fq : nullptr);
        side.end(fr + 16 * fq, sst);
    }
};
template <bool I8 = false, bool WXB = true, bool ADDY = false> struct EpiRes {
    static constexpr bool PERM = false, AFTER_DRAIN = false, CHAIN = false;
    const float* xin; float* xout; bf16_t* xb; unsigned long long* rowsq_out; int ldc; const PG8_LAS float* tab; const float* sw; const bf16_t* y;
    typedef NoPre Pre;
    __device__ __forceinline__ void prefetch(const Unit&, int, int, int, int, Pre&) const {}
    __device__ __forceinline__ void operator()(const f32x4 (&acc)[2][2][4][2], const Unit& u, int wr, int wc, int fr, int fq, const Pre&) const {
        typedef unsigned u32x2v __attribute__((ext_vector_type(2)));
        const int row0 = u.pm * BM + wr * 64 + fr, col0 = u.pn * BM + wc * 32 + 4 * fq;
        f32x4 swv[2][2];
        if constexpr (I8) {
#pragma unroll
            for (int bj = 0; bj < 2; ++bj)
#pragma unroll
                for (int n = 0; n < 2; ++n) swv[bj][n] = *(const f32x4*)(sw + col0 + bj * HALF + n * 16); }
        constexpr int MB = ADDY ? 2 : 4;
#pragma unroll
        for (int ab = 0; ab < 2 * (4 / MB); ++ab) { const int ai = ab / (4 / MB), m0 = (ab % (4 / MB)) * MB;
            f32x4 xo[4][2][2]; u32x2v yo[4][2][2];
#pragma unroll
            for (int m = m0; m < m0 + MB; ++m)
#pragma unroll
                for (int bj = 0; bj < 2; ++bj)
#pragma unroll
                    for (int n = 0; n < 2; ++n) { xo[m][bj][n] = *(const f32x4*)(xin + (size_t)(row0 + ai * HALF + m * 16) * ldc + col0 + bj * HALF + n * 16);
                        if constexpr (ADDY) yo[m][bj][n] = *(const u32x2v*)(y + (size_t)(row0 + ai * HALF + m * 16) * ldc + col0 + bj * HALF + n * 16); }
#pragma unroll
            for (int m = m0; m < m0 + MB; ++m) { const int row = row0 + ai * HALF + m * 16; const size_t off = (size_t)row * ldc + col0; float ss = 0.f;
#pragma unroll
                for (int bj = 0; bj < 2; ++bj)
#pragma unroll
                    for (int n = 0; n < 2; ++n) { f32x4 av = acc[ai][bj][m][n];
                        if constexpr (I8) { const i32x4_t a = __builtin_bit_cast(i32x4_t, av); av = (f32x4){(float)a[0], (float)a[1], (float)a[2], (float)a[3]} * swv[bj][n] * tab[wr * 64 + fr + ai * HALF + m * 16]; }
                        f32x4 xr = xo[m][bj][n];
                        if constexpr (ADDY) { const u32x2v yw = yo[m][bj][n]; xr = xr + (f32x4){bf_lo(yw.x), bf_hi(yw.x), bf_lo(yw.y), bf_hi(yw.y)}; }
                        const f32x4 xn = xr + av;
                        *(f32x4*)(xout + off + bj * HALF + n * 16) = xn;
                        if constexpr (WXB) { u32x2v w; w.x = cvt_pk_bf16(xn[0], xn[1]); w.y = cvt_pk_bf16(xn[2], xn[3]); *(u32x2v*)(xb + off + bj * HALF + n * 16) = w;
                            ss += (xn[0] * xn[0] + xn[1] * xn[1]) + (xn[2] * xn[2] + xn[3] * xn[3]); } }
                if constexpr (WXB) { ss += __shfl_xor(ss, 16); ss += __shfl_xor(ss, 32);
                    if (rowsq_out != nullptr && fq == 0) __hip_atomic_fetch_add(rowsq_out + row, (unsigned long long)(ss * 16777216.0f + 0.5f), __ATOMIC_RELAXED, __HIP_MEMORY_SCOPE_AGENT); } }
            asm volatile("" ::: "memory"); }
    }
};
struct EpiBf {
    static constexpr bool PERM = true, AFTER_DRAIN = false, CHAIN = false;
    bf16_t* O; int ldc;
    typedef NoPre Pre;
    __device__ __forceinline__ void prefetch(const Unit&, int, int, int, int, Pre&) const {}
    __device__ __forceinline__ void operator()(const f32x4 (&acc)[2][2][4][2], const Unit& u, int wr, int wc, int fr, int fq, const Pre&) const {
        const int row0 = u.pm * BM + wr * 64 + fr, col0 = u.pn * BM + wc * 32 + 8 * fq;
        const float rs[2][4] = {{1.f, 1.f, 1.f, 1.f}, {1.f, 1.f, 1.f, 1.f}};
        act_store_bf16<0, false>(acc, rs, O + (size_t)row0 * ldc + col0, ldc);
    }
};
struct EpiYab {
    static constexpr bool PERM = true, AFTER_DRAIN = false, CHAIN = true;
    const bf16_t* proj; bf16_t* MG; int ldp, ga_col, gb_col, ldc, nM1, nN1; const unsigned char* g8;
    typedef NoPre Pre;
    __device__ __forceinline__ void prefetch(const Unit&, int, int, int, int, Pre&) const {}
    __device__ __forceinline__ bool chain(f32x4 (&acc)[2][2][4][2], const Unit& u, int wr, int wc, int fr, int fq) const {
        const bool second = u.pm >= nM1; const int pm = second ? u.pm - nM1 : u.pm, pn = second ? u.pn - nN1 : u.pn;
        const int row0 = pm * BM + wr * 64 + fr, col0 = pn * BM + wc * 32 + 8 * fq; constexpr float TINY = 8.673617379884035e-19f;
#if GATES8
        const unsigned char* gt = g8 + ((size_t)(pm * 8 + pn) << 16) + (wr * 4 + wc) * 8192 + (fr + 16 * fq) * 16;
#define UB4(w) ((f32x4){(float)((w) & 255u), (float)(((w) >> 8) & 255u), (float)(((w) >> 16) & 255u), (float)((w) >> 24)} * (1.0f / 255.0f))
#endif
#if GATES8
        u32x4 gbq8[8], gaq8[8];
#pragma unroll
        for (int k = 0; k < 8; ++k) { gbq8[k] = *(const u32x4*)(gt + ((size_t)512 << 16) + k * 1024); if (!second) gaq8[k] = *(const u32x4*)(gt + k * 1024); }
#endif
#pragma unroll
        for (int ai = 0; ai < 2; ++ai) {
#if GATES8
            u32x4 gbq[4], gaq[4];
#pragma unroll
            for (int k = 0; k < 4; ++k) { gbq[k] = gbq8[ai * 4 + k]; if (!second) gaq[k] = gaq8[ai * 4 + k]; }
#else
            u32x4 gb[4][2], ga[4][2];
#pragma unroll
            for (int m = 0; m < 4; ++m)
#pragma unroll
                for (int bj = 0; bj < 2; ++bj) { const bf16_t* gp = proj + (size_t)(row0 + ai * HALF + m * 16) * ldp + col0 + bj * HALF; gb[m][bj] = *(const u32x4*)(gp + gb_col); if (!second) ga[m][bj] = *(const u32x4*)(gp + ga_col); }
#endif
#pragma unroll
            for (int m = 0; m < 4; ++m)
#pragma unroll
                for (int bj = 0; bj < 2; ++bj) {
#if GATES8
                    const unsigned glo = (m & 1) ? gbq[bj * 2 + (m >> 1)].z : gbq[bj * 2 + (m >> 1)].x, ghi = (m & 1) ? gbq[bj * 2 + (m >> 1)].w : gbq[bj * 2 + (m >> 1)].y;
                    const f32x4 g0 = UB4(glo), g1 = UB4(ghi);
                    const f32x4 b0 = (f32x4){fmaxf(g0[0], TINY), fmaxf(g0[1], TINY), fmaxf(g0[2], TINY), fmaxf(g0[3], TINY)}, b1 = (f32x4){fmaxf(g1[0], TINY), fmaxf(g1[1], TINY), fmaxf(g1[2], TINY), fmaxf(g1[3], TINY)};
                    if (!second) { const unsigned alo = (m & 1) ? gaq[bj * 2 + (m >> 1)].z : gaq[bj * 2 + (m >> 1)].x, ahi = (m & 1) ? gaq[bj * 2 + (m >> 1)].w : gaq[bj * 2 + (m >> 1)].y;
                        const f32x4 a0 = UB4(alo), a1 = UB4(ahi);
                        const f32x4 r0 = (f32x4){a0[0] * __builtin_amdgcn_rcpf(b0[0]), a0[1] * __builtin_amdgcn_rcpf(b0[1]), a0[2] * __builtin_amdgcn_rcpf(b0[2]), a0[3] * __builtin_amdgcn_rcpf(b0[3])};
                        const f32x4 r1 = (f32x4){a1[0] * __builtin_amdgcn_rcpf(b1[0]), a1[1] * __builtin_amdgcn_rcpf(b1[1]), a1[2] * __builtin_amdgcn_rcpf(b1[2]), a1[3] * __builtin_amdgcn_rcpf(b1[3])};
                        acc[ai][bj][m][0] *= r0; acc[ai][bj][m][1] *= r1; }
#else
                    const u32x4 g = gb[m][bj];
                    const f32x4 b0 = (f32x4){fmaxf(bf_lo(g.x), TINY), fmaxf(bf_hi(g.x), TINY), fmaxf(bf_lo(g.y), TINY), fmaxf(bf_hi(g.y), TINY)}, b1 = (f32x4){fmaxf(bf_lo(g.z), TINY), fmaxf(bf_hi(g.z), TINY), fmaxf(bf_lo(g.w), TINY), fmaxf(bf_hi(g.w), TINY)};
                    if (!second) { const u32x4 a = ga[m][bj];
                        const f32x4 r0 = (f32x4){bf_lo(a.x) * __builtin_amdgcn_rcpf(b0[0]), bf_hi(a.x) * __builtin_amdgcn_rcpf(b0[1]), bf_lo(a.y) * __builtin_amdgcn_rcpf(b0[2]), bf_hi(a.y) * __builtin_amdgcn_rcpf(b0[3])};
                        const f32x4 r1 = (f32x4){bf_lo(a.z) * __builtin_amdgcn_rcpf(b1[0]), bf_hi(a.z) * __builtin_amdgcn_rcpf(b1[1]), bf_lo(a.w) * __builtin_amdgcn_rcpf(b1[2]), bf_hi(a.w) * __builtin_amdgcn_rcpf(b1[3])};
                        acc[ai][bj][m][0] *= r0; acc[ai][bj][m][1] *= r1; }
#endif
                    else { const f32x4 v0 = acc[ai][bj][m][0] * b0, v1 = acc[ai][bj][m][1] * b1;
                        u32x4 w; w.x = cvt_pk_bf16(v0[0], v0[1]); w.y = cvt_pk_bf16(v0[2], v0[3]); w.z = cvt_pk_bf16(v1[0], v1[1]); w.w = cvt_pk_bf16(v1[2], v1[3]);
                        *(u32x4*)(MG + (size_t)(row0 + ai * HALF + m * 16) * ldc + col0 + bj * HALF) = w; } }
            asm volatile("" ::: "memory"); }
#if GATES8
#undef UB4
#endif
        return !second;
    }
};
struct EpiNull {
    static constexpr bool PERM = true, AFTER_DRAIN = false, CHAIN = false;
    float* sink;
    typedef NoPre Pre;
    __device__ __forceinline__ void prefetch(const Unit&, int, int, int, int, Pre&) const {}
    __device__ __forceinline__ void operator()(const f32x4 (&acc)[2][2][4][2], const Unit& u, int wr, int wc, int fr, int fq, const Pre&) const {
        if (u.pm < 0) { f32x4 t = (f32x4){0.f, 0.f, 0.f, 0.f};
#pragma unroll
            for (int ai = 0; ai < 2; ++ai)
#pragma unroll
                for (int bj = 0; bj < 2; ++bj)
#pragma unroll
                    for (int m = 0; m < 4; ++m)
#pragma unroll
                        for (int n = 0; n < 2; ++n) t += acc[ai][bj][m][n];
            *(f32x4*)(sink + (wr * 256 + wc * 64 + fq * 16 + fr) * 4) = t; }
    }
};
struct YabOrder {
    StaticOrder so; int nM1, nN1;
    __host__ __device__ void init(int M1, int N1, int G_, int c_) { so.init(M1, N1, G_, c_); nM1 = M1 / BM; nN1 = N1 / BM; }
    __host__ __device__ bool next(int i, Unit& u) const { if (!so.next(i >> 1, u)) return false; if (i & 1) { u.pm += nM1; u.pn += nN1; } return true; }
    __device__ __forceinline__ void a_ready(const Unit&) const {}
    __device__ __forceinline__ void done(const Unit&) const {}
};


struct FfnOrder {
    StaticOrder so; int c, hf, nN, rot; bool loc;
    __host__ __device__ void init(int Mh, int N, int G_, int c_, int hf_) { so.init(Mh, N, G_, c_); c = c_; hf = hf_; nN = N / BM; loc = FFN_LOCAL && G_ == 256 && Mh / BM == 32 && (nN % 8) == 0; rot = (GEMM_ROT * (c_ % NXCD)) % nN; }
    __host__ __device__ int partner(int pm) const { return loc ? pm + 4 : pm + so.nM; }
    __host__ __device__ bool next(int i, Unit& u) const {
        if (!loc) { StaticOrder s2 = so; s2.c = c; if (!s2.next(i, u)) return false; u.pm += hf * so.nM; return true; }
        if (i >= nN / 8) return false;
        const int x = c & 7, j = c >> 3, jj = j & 7, k = j >> 3;
        u.pm = 8 * x + 4 * hf + (jj & 3); u.pn = (((jj >> 2) << 2) + k + 8 * i + rot) % nN; return true;
    }
    __device__ __forceinline__ void a_ready(const Unit&) const {}
    __device__ __forceinline__ void done(const Unit&) const {}
};
struct SameOrder {
    int n, z;
    __host__ __device__ bool next(int i, Unit& u) const { if (i >= n) return false; u.pm = z; u.pn = z; return true; }
    __device__ __forceinline__ void a_ready(const Unit&) const {}
    __device__ __forceinline__ void done(const Unit&) const {}
};

struct SubOrder {
    StaticOrder so; int off, cnt;
    __host__ __device__ bool next(int i, Unit& u) const { if (i >= cnt) return false; return so.next(i + off, u); }
    __device__ __forceinline__ void a_ready(const Unit&) const {}
    __device__ __forceinline__ void done(const Unit&) const {}
};

struct InProjOrder {
    StaticOrder so; int x;
    __host__ __device__ void init(int M, int N, int G_, int c_) { so.init(M, N, G_, c_); so.rot = 0; x = c_ % NXCD; }
    __host__ __device__ bool next(int i, Unit& u) const {
        if (!so.next(i, u)) return false;
        if (so.nN != 36) return true;
        const int rnd = u.pn >> 2, j = u.pn & 3; const int nr = rnd < 4 ? 5 + ((rnd + x) & 3) : (rnd - 4 + x) % 5;
        u.pn = 4 * nr + j; return true;
    }
    __device__ __forceinline__ void a_ready(const Unit&) const {}
    __device__ __forceinline__ void done(const Unit&) const {}
};
template <class Epi, class Sched, bool ALIGN_EPI = false, bool SP2 = false, int MMA = 0  >
__device__ __forceinline__ void gemm_phase(PG8_LAS unsigned char* lds, const Gemm g, const Sched& S, const Epi& E) {
    const int tid = threadIdx.x, wid = __builtin_amdgcn_readfirstlane(tid >> 6), lane = tid & 63, wr = wid >> 2, wc = wid & 3, fr = lane & 15, fq = lane >> 4;
    const int K = g.K, nt = K / BK;
    unsigned voffA[2], voffB[2];
#pragma unroll
    for (int i = 0; i < 2; ++i) { int R, C; stage_rc(tid * 16 + i * 8192, R, C); const int Rb = Epi::PERM ? ((R & ~31) + perm32(R & 31)) : R;
        voffA[i] = (unsigned)(R * K + C) * 2u; voffB[i] = (unsigned)(Rb * K + C) * 2u; }
    const size_t kstep = (size_t)(BK * 2);
    const int kmask = nt - 1, t0 = ((nt & kmask) == 0) ? (g.krot & kmask) : 0;
#define PG8_KO(j) ((size_t)(((j) + t0) & kmask) * kstep)
    const size_t hstep = (size_t)HALF * K * 2;
    const size_t tstep = 2 * hstep;
    const unsigned ldsw = (unsigned)wid * 1024u;
    const int aoff = lds_byte(wr * 64 + fr, fq * 8), boff = lds_byte(wc * 32 + fr, fq * 8);
#define PG8_SA(b, h) (((b) * 2 + (h)) * HTB)
#define PG8_SB(b, h) ((4 + (b) * 2 + (h)) * HTB)
#define PG8_STAGE(bufoff, gbase, voff) do { _Pragma("unroll") for (int _i = 0; _i < 2; ++_i) \
        __builtin_amdgcn_global_load_lds((const unsigned*)((const char*)(gbase) + (voff)[_i]), (PG8_LAS unsigned*)(lds + (bufoff) + ldsw + _i * 8192), 16, 0, 0); } while (0)
#define PG8_LDA(dst, b, h) do { _Pragma("unroll") for (int m = 0; m < 4; ++m) _Pragma("unroll") for (int k = 0; k < 2; ++k) dst[m][k] = *(const PG8_LAS bf16x8*)(lds + PG8_SA(b, h) + aoff + m * 2048 + k * 1024); } while (0)
#define PG8_LDB(dst, b, h) do { _Pragma("unroll") for (int n = 0; n < 2; ++n) _Pragma("unroll") for (int k = 0; k < 2; ++k) dst[n][k] = *(const PG8_LAS bf16x8*)(lds + PG8_SB(b, h) + boff + n * 2048 + k * 1024); } while (0)
#define PG8_MMA(ai, bj, At, Bt) do { __builtin_amdgcn_s_setprio(1); _Pragma("unroll") for (int m = 0; m < 4; ++m) _Pragma("unroll") for (int n = 0; n < 2; ++n) _Pragma("unroll") for (int k = 0; k < 2; ++k) \
        { if constexpr (MMA == 1) acc[ai][bj][m][n] = __builtin_bit_cast(f32x4, __builtin_amdgcn_mfma_i32_16x16x64_i8(__builtin_bit_cast(i32x4_t, Bt[n][k]), __builtin_bit_cast(i32x4_t, At[m][k]), __builtin_bit_cast(i32x4_t, acc[ai][bj][m][n]), 0, 0, 0)); \
          else acc[ai][bj][m][n] = __builtin_amdgcn_mfma_f32_16x16x32_bf16(Bt[n][k], At[m][k], acc[ai][bj][m][n], 0, 0, 0); } __builtin_amdgcn_s_setprio(0); } while (0)
#define PG8_WAIT_V(n) asm volatile("s_waitcnt vmcnt(" #n ")" ::: "memory")
#define PG8_WAIT_L(n) asm volatile("s_waitcnt lgkmcnt(" #n ")" ::: "memory")
#define PG8_BAR __builtin_amdgcn_s_barrier()
#define PG8_SCHED __builtin_amdgcn_sched_barrier(0)
    Unit cur, nxt; int ui = 0;
    if (!S.next(0, cur)) return;
    f32x4 acc[2][2][4][2];
    typename Epi::Pre pre;
#pragma unroll
    for (int a = 0; a < 2; ++a)
#pragma unroll
        for (int b = 0; b < 2; ++b)
#pragma unroll
            for (int m = 0; m < 4; ++m)
#pragma unroll
                for (int n = 0; n < 2; ++n) acc[a][b][m][n] = (f32x4){0.f, 0.f, 0.f, 0.f};
    bf16x8 At[4][2], B0[2][2], B1[2][2];
    const char* cA = (const char*)g.A + (size_t)cur.pm * tstep; const char* cB = (const char*)g.Bt + (size_t)cur.pn * tstep;
    S.a_ready(cur);
    if constexpr (SP2) {
        PG8_STAGE(PG8_SB(0, 0), cB + PG8_KO(0), voffB); PG8_STAGE(PG8_SB(0, 1), cB + hstep + PG8_KO(0), voffB); PG8_STAGE(PG8_SA(0, 0), cA + PG8_KO(0), voffA); PG8_STAGE(PG8_SA(0, 1), cA + hstep + PG8_KO(0), voffA);
        if (wr == 1) PG8_BAR;
        PG8_WAIT_V(2); PG8_BAR;
        PG8_STAGE(PG8_SB(1, 0), cB + PG8_KO(1), voffB); PG8_STAGE(PG8_SA(1, 0), cA + PG8_KO(1), voffA); PG8_STAGE(PG8_SB(1, 1), cB + hstep + PG8_KO(1), voffB);
        PG8_WAIT_V(6); PG8_BAR;
    } else {
        PG8_STAGE(PG8_SB(0, 0), cB + PG8_KO(0), voffB); PG8_STAGE(PG8_SA(0, 0), cA + PG8_KO(0), voffA); PG8_STAGE(PG8_SB(0, 1), cB + hstep + PG8_KO(0), voffB); PG8_STAGE(PG8_SA(0, 1), cA + hstep + PG8_KO(0), voffA);
        if (wr == 1) PG8_BAR;
        PG8_WAIT_V(4); PG8_BAR;
        PG8_STAGE(PG8_SB(1, 0), cB + PG8_KO(1), voffB); PG8_STAGE(PG8_SA(1, 0), cA + PG8_KO(1), voffA); PG8_STAGE(PG8_SB(1, 1), cB + hstep + PG8_KO(1), voffB);
        PG8_WAIT_V(6); PG8_BAR;
    }
    for (;;) {
        const bool has_next = S.next(ui + 1, nxt);
        const char* nA = has_next ? (const char*)g.A + (size_t)nxt.pm * tstep : cA; const char* nB = has_next ? (const char*)g.Bt + (size_t)nxt.pn * tstep : cB;
        for (int t = 0; t < nt; t += 2) {
            const bool last = (t == nt - 2);
            const char* a1 = cA + PG8_KO(t + 1);
            const char* a2 = last ? nA + PG8_KO(0) : cA + PG8_KO(t + 2); const char* b2 = last ? nB + PG8_KO(0) : cB + PG8_KO(t + 2);
            const char* a3 = last ? nA + PG8_KO(1) : cA + PG8_KO(t + 3); const char* b3 = last ? nB + PG8_KO(1) : cB + PG8_KO(t + 3);
            if (last) E.prefetch(cur, wr, wc, fr, fq, pre);
            if (last && has_next) S.a_ready(nxt);
            if constexpr (SP2) {
            PG8_LDB(B0, 0, 0); PG8_LDB(B1, 0, 1); PG8_SCHED; PG8_LDA(At, 0, 0); PG8_STAGE(PG8_SA(1, 1), a1 + hstep, voffA);
            PG8_WAIT_V(8); PG8_WAIT_L(0); PG8_BAR; PG8_MMA(0, 0, At, B0); PG8_MMA(0, 1, At, B1); PG8_BAR; PG8_SCHED;
            PG8_LDA(At, 0, 1); PG8_STAGE(PG8_SB(0, 0), b2, voffB); PG8_STAGE(PG8_SB(0, 1), b2 + hstep, voffB); PG8_STAGE(PG8_SA(0, 0), a2, voffA);
            PG8_WAIT_V(8); PG8_WAIT_L(0); PG8_BAR; PG8_MMA(1, 0, At, B0); PG8_MMA(1, 1, At, B1); PG8_BAR; PG8_SCHED;
            PG8_LDB(B0, 1, 0); PG8_LDB(B1, 1, 1); PG8_SCHED; PG8_LDA(At, 1, 0); PG8_STAGE(PG8_SA(0, 1), a2 + hstep, voffA);
            PG8_WAIT_V(8); PG8_WAIT_L(0); PG8_BAR; PG8_MMA(0, 0, At, B0); PG8_MMA(0, 1, At, B1); PG8_BAR; PG8_SCHED;
            PG8_LDA(At, 1, 1); PG8_STAGE(PG8_SB(1, 0), b3, voffB); PG8_STAGE(PG8_SB(1, 1), b3 + hstep, voffB); PG8_STAGE(PG8_SA(1, 0), a3, voffA);
            PG8_WAIT_V(8); PG8_WAIT_L(0); PG8_BAR; PG8_MMA(1, 0, At, B0); PG8_MMA(1, 1, At, B1); PG8_BAR; PG8_SCHED;
            } else {
            PG8_LDB(B0, 0, 0); PG8_SCHED; PG8_LDA(At, 0, 0); PG8_STAGE(PG8_SA(1, 1), a1 + hstep, voffA);
            PG8_WAIT_L(8); PG8_BAR; PG8_WAIT_L(0); PG8_MMA(0, 0, At, B0); PG8_BAR; PG8_SCHED;
            PG8_LDB(B1, 0, 1); PG8_STAGE(PG8_SB(0, 0), b2, voffB);
            PG8_BAR; PG8_WAIT_L(0); PG8_MMA(0, 1, At, B1); PG8_BAR;
            PG8_LDA(At, 0, 1); PG8_STAGE(PG8_SA(0, 0), a2, voffA);
            PG8_BAR; PG8_WAIT_L(0); PG8_MMA(1, 0, At, B0); PG8_BAR; PG8_SCHED;
            PG8_STAGE(PG8_SB(0, 1), b2 + hstep, voffB);
            PG8_WAIT_V(6); PG8_BAR; PG8_MMA(1, 1, At, B1); PG8_BAR;
            PG8_LDB(B0, 1, 0); PG8_SCHED; PG8_LDA(At, 1, 0); PG8_STAGE(PG8_SA(0, 1), a2 + hstep, voffA);
            PG8_WAIT_L(8); PG8_BAR; PG8_WAIT_L(0); PG8_MMA(0, 0, At, B0); PG8_BAR; PG8_SCHED;
            PG8_LDB(B1, 1, 1); PG8_STAGE(PG8_SB(1, 0), b3, voffB);
            PG8_BAR; PG8_WAIT_L(0); PG8_MMA(0, 1, At, B1); PG8_BAR;
            PG8_LDA(At, 1, 1); PG8_STAGE(PG8_SA(1, 0), a3, voffA);
            PG8_BAR; PG8_WAIT_L(0); PG8_MMA(1, 0, At, B0); PG8_BAR; PG8_SCHED;
            PG8_STAGE(PG8_SB(1, 1), b3 + hstep, voffB);
            PG8_WAIT_V(6); PG8_BAR; PG8_MMA(1, 1, At, B1); PG8_BAR;
            }
        }
        if constexpr (ALIGN_EPI) { if (wr == 0) PG8_BAR; }
        cur.ord = ui;
        bool keep = false;
        if constexpr (!Epi::AFTER_DRAIN) { if constexpr (Epi::CHAIN) keep = E.chain(acc, cur, wr, wc, fr, fq); else E(acc, cur, wr, wc, fr, fq, pre); S.done(cur);
#if EPI_DRAIN
            asm volatile("s_waitcnt vmcnt(0)" ::: "memory");
#endif
        }
        if (!has_next) break;
        if (!keep)
#pragma unroll
        for (int a = 0; a < 2; ++a)
#pragma unroll
            for (int b = 0; b < 2; ++b)
#pragma unroll
                for (int m = 0; m < 4; ++m)
#pragma unroll
                    for (int n = 0; n < 2; ++n) acc[a][b][m][n] = (f32x4){0.f, 0.f, 0.f, 0.f};
        cur = nxt; cA = nA; cB = nB; ++ui;
        if constexpr (ALIGN_EPI) { if (wr == 1) PG8_BAR; }
    }
    PG8_WAIT_V(0);
    if constexpr (!ALIGN_EPI) { if (wr == 0) PG8_BAR; }
    PG8_BAR;
    if constexpr (Epi::AFTER_DRAIN) { E.fused(acc, cur, wr, wc, fr, fq, lds, wid, lane); S.done(cur); }
#undef PG8_KO
#undef PG8_SA
#undef PG8_SB
#undef PG8_STAGE
#undef PG8_LDA
#undef PG8_LDB
#undef PG8_MMA
#undef PG8_WAIT_V
#undef PG8_WAIT_L
#undef PG8_BAR
#undef PG8_SCHED
}
}

constexpr int NWAVES = 8;
constexpr int BATCH = 2, SEQ = 8192, D = 2048, DEPTH = 4, M = BATCH * SEQ;
constexpr int NH = 8, HD = 128, SBW = 1024, SGW = 1024, NG = 8, GD = 128, SL = 128, DFF = 8192, INC = 9216;
constexpr int C_Q = 0, C_K = 1024, C_V = 2048, C_U = 3072, C_VS = 4096, C_GA = 5120, C_GB = 7168;
constexpr float EPS = 1e-6f;
constexpr float SB_STOP = -44.0f;

constexpr size_t MiB = 1u << 20;
constexpr size_t WS_CTL = 0, CTL_ZERO_BYTES = 4 * MiB;
constexpr size_t WS_RS = 1 * MiB;
constexpr size_t WS_WIN = 4 * MiB;
constexpr size_t WS_WOAB = WS_WIN + 4 * 36 * MiB;
constexpr size_t WS_WOUT = WS_WOAB + 4 * 8 * MiB;
constexpr size_t WS_W1 = WS_WOUT + 4 * 8 * MiB;
constexpr size_t WS_W2 = WS_W1 + 4 * 32 * MiB;
constexpr size_t WS_WSP = WS_W2 + 4 * 32 * MiB;
constexpr size_t WS_XB = WS_WSP + 2 * MiB;
constexpr size_t WS_PROJ = WS_XB + 64 * MiB;
constexpr size_t WS_OS = WS_PROJ + 288 * MiB;
constexpr size_t WS_T = WS_OS + 64 * MiB;
constexpr size_t WS_MG = WS_T + 128 * MiB;
constexpr size_t WS_END = WS_MG + 64 * MiB;
constexpr size_t WS_XB8 = WS_T;
constexpr size_t WS_WIN8 = WS_T + 32 * MiB;
constexpr size_t WS_SWIN = WS_T + 104 * MiB;
constexpr size_t WS_SX = WS_T + 105 * MiB;
constexpr size_t WS_G8 = WS_W1;
constexpr size_t WS_W18 = WS_WIN;
constexpr size_t WS_SW1 = WS_WIN + 64 * MiB;
constexpr size_t WS_WOUT8 = WS_WIN + 66 * MiB;
constexpr size_t WS_SWOUT = WS_WIN + 82 * MiB;
static_assert((size_t)DEPTH * INC * D * 2 == 4 * 36 * MiB && (size_t)M * INC * 2 == 288 * MiB && (size_t)M * D * 4 == 128 * MiB, "d_ws map");
constexpr int CW_TMO = 0, CW_CODE = 1;
constexpr int CW_BAR = 4096;

constexpr int RING_OFF = 0, RING_BYTES = 131072;
constexpr int SCR_BYTES = 143360;
constexpr int LDSCTL_OFF = SCR_BYTES, MISC_OFF = LDSCTL_OFF + 320;
constexpr int LDS_BYTES = 147456;
static_assert(MISC_OFF + 128 <= LDS_BYTES, "LDS map");

#define GAS __attribute__((address_space(1)))
#define LAS __attribute__((address_space(3)))
typedef unsigned short bf16;
typedef unsigned v4u __attribute__((ext_vector_type(4)));
typedef unsigned v2u __attribute__((ext_vector_type(2)));
typedef float f32x4 __attribute__((ext_vector_type(4)));
typedef float f32x2 __attribute__((ext_vector_type(2)));
typedef float f32x16 __attribute__((ext_vector_type(16)));
typedef short bf16x8 __attribute__((ext_vector_type(8)));
typedef short s16x4 __attribute__((ext_vector_type(4)));
typedef GAS unsigned gu32;
#define RLX_AGENT __ATOMIC_RELAXED, __HIP_MEMORY_SCOPE_AGENT
#define LDS_WAIT() asm volatile("s_waitcnt lgkmcnt(0)" ::: "memory")
#define VM_WAIT() asm volatile("s_waitcnt vmcnt(0)" ::: "memory")
__device__ __forceinline__ unsigned f2bf(float f) { unsigned u = __builtin_bit_cast(unsigned, f); return (u + 0x7fffu + ((u >> 16) & 1u)) >> 16; }
__device__ __forceinline__ unsigned pk2(float lo, float hi) { return f2bf(lo) | (f2bf(hi) << 16); }
__device__ __forceinline__ float bflo(unsigned w) { return __uint_as_float(w << 16); }
__device__ __forceinline__ float bfhi(unsigned w) { return __uint_as_float(w & 0xffff0000u); }

#define XB_TMO      128
#define XB_XCNT(j)  (256  + 64 * (j))
#define XB_XSUB(j)  (1280 + 64 * (j))
#define XB_XGEN(j)  (2304 + 64 * (j))
#define XB_TOP      3328
#define XB_TOPGEN   3392
#define XCD_BAR_WORDS 3456
#define XB_SPIN_CAP (1u << 18)

__device__ __forceinline__ unsigned xb_ld(unsigned* p)              { return __hip_atomic_load(p, __ATOMIC_RELAXED, __HIP_MEMORY_SCOPE_AGENT); }
__device__ __forceinline__ unsigned xb_add(unsigned* p, unsigned v) { return __hip_atomic_fetch_add(p, v, __ATOMIC_RELAXED, __HIP_MEMORY_SCOPE_AGENT); }
__device__ __forceinline__ unsigned xb_xcc_id() { return (unsigned)__builtin_amdgcn_s_getreg((3 << 11) | 20) & 0xFu; }
#define XB_SPIN(cond, bar) do { unsigned _sp = 0; while (cond) { __builtin_amdgcn_s_sleep(1); \
    if ((++_sp & 255u) == 0u) { if (xb_ld(&(bar)[XB_TMO])) break; if (_sp > XB_SPIN_CAP) { atomicAdd(&(bar)[XB_TMO], 1u); break; } } } } while (0)

struct XcdBarrier {
    unsigned* bar; unsigned x;
    volatile LAS unsigned* st;
};

__device__ __forceinline__ XcdBarrier xcd_barrier_post(unsigned* bar, volatile LAS unsigned* st) {
    XcdBarrier b; b.bar = bar; b.x = xb_xcc_id(); b.st = st;
    if (threadIdx.x == 0) (void)xb_add(&bar[XB_XCNT(b.x)], 1u);
    return b;
}
__device__ __forceinline__ void xcd_barrier_complete(unsigned* bar, unsigned x, unsigned& nloc, unsigned& nx) {
    const unsigned G = gridDim.x * gridDim.y * gridDim.z;
    unsigned sum, cnt, mine, sp = 0u;
    for (;;) {
        sum = 0u; cnt = 0u; mine = 0u;
#pragma unroll
        for (unsigned j = 0; j < 16; ++j) { const unsigned c = xb_ld(&bar[XB_XCNT(j)]); sum += c; cnt += (c > 0u) ? 1u : 0u; mine = (j == x) ? c : mine; }
        if (sum == G) break;
        __builtin_amdgcn_s_sleep(1);
        if ((++sp & 255u) == 0u) { if (xb_ld(&bar[XB_TMO])) break; if (sp > XB_SPIN_CAP) { atomicAdd(&bar[XB_TMO], 1u); break; } }
    }
    nloc = mine > 0u ? mine : 1u; nx = cnt > 0u ? cnt : 1u;
}

__device__ __forceinline__ void xcd_barrier(const XcdBarrier& b) {
    asm volatile("s_waitcnt vmcnt(0)" ::: "memory");
    __syncthreads();
    if (threadIdx.x == 0) {
        unsigned* bar = b.bar;
        __builtin_amdgcn_s_waitcnt(0);
        unsigned nloc = b.st[0], nx = b.st[1];
        if (nloc == 0u) { xcd_barrier_complete(bar, b.x, nloc, nx); b.st[0] = nloc; b.st[1] = nx; }
        const unsigned old = xb_add(&bar[XB_XSUB(b.x)], 1u);
        const unsigned gen = old / nloc;
        if (old + 1u == (gen + 1u) * nloc) {
            __builtin_amdgcn_fence(__ATOMIC_RELEASE, "agent");
            asm volatile("s_waitcnt vmcnt(0)" ::: "memory");
            const unsigned og = xb_add(&bar[XB_TOP], 1u);
            const unsigned tg = og / nx;
            if (og + 1u == (tg + 1u) * nx) xb_add(&bar[XB_TOPGEN], 1u);
            else XB_SPIN(xb_ld(&bar[XB_TOPGEN]) == tg, bar);
            __builtin_amdgcn_fence(__ATOMIC_ACQUIRE, "agent");
            xb_add(&bar[XB_XGEN(b.x)], 1u);
            asm volatile("s_waitcnt vmcnt(0)" ::: "memory");
        } else {
            XB_SPIN(xb_ld(&bar[XB_XGEN(b.x)]) == gen, bar);
            __builtin_amdgcn_fence(__ATOMIC_ACQUIRE, "agent");
            asm volatile("s_waitcnt vmcnt(0)" ::: "memory");
        }
    }
    __syncthreads();
}

struct Frame {
    LAS unsigned char* lds;
    volatile LAS unsigned* MISC;
    gu32* ctl;
    int tid, lane, wave;
    int vcu, G;
};
__device__ __forceinline__ float wave_sum(float v) {
#pragma unroll
    for (int o = 1; o < 64; o <<= 1) v += __shfl_xor(v, o);
    return v;
}

struct Args { const float* in[15]; float* out; unsigned char* ws; int ph_lo, ph_hi; };
template <int K, int N> __device__ __forceinline__ void tr_load(const float* W, const float* gain, int item, int lane, f32x4 (&v)[8]) {
    constexpr int nblk = N / 32; const int kq = item / nblk, nb = item % nblk, k8 = 64 * kq + 8 * (lane & 7), n4 = 32 * nb + 4 * (lane >> 3);
    const float* src = W + (size_t)k8 * N + n4;
#pragma unroll
    for (int e = 0; e < 8; ++e) v[e] = *(const GAS f32x4*)(src + (size_t)e * N);
    if (gain) { const f32x4 g0 = *(const GAS f32x4*)(gain + k8), g1 = *(const GAS f32x4*)(gain + k8 + 4);
        v[0] = v[0] * g0.x; v[1] = v[1] * g0.y; v[2] = v[2] * g0.z; v[3] = v[3] * g0.w; v[4] = v[4] * g1.x; v[5] = v[5] * g1.y; v[6] = v[6] * g1.z; v[7] = v[7] * g1.w; }
}
template <int K, int N> __device__ __forceinline__ void tr_store(bf16* WT, int item, int lane, const f32x4 (&v)[8]) {
    constexpr int nblk = N / 32; const int kq = item / nblk, nb = item % nblk, k8 = 64 * kq + 8 * (lane & 7), n4 = 32 * nb + 4 * (lane >> 3);
    bf16* dst = WT + (size_t)n4 * K + k8;
#pragma unroll
    for (int j = 0; j < 4; ++j) { v4u o; o.x = pk2(v[0][j], v[1][j]); o.y = pk2(v[2][j], v[3][j]); o.z = pk2(v[4][j], v[5][j]); o.w = pk2(v[6][j], v[7][j]); *(GAS v4u*)(dst + (size_t)j * K) = o; }
}
template <int K, int N> __device__ __forceinline__ int convert_matrix(const float* W, const float* gain, bf16* WT, int slot, int nslot, int first, int lane) {
    constexpr int NI = (K / 64) * (N / 32);
    int s0 = slot - first; if (s0 < 0) s0 += nslot;
    for (int it = s0; it < NI; it += 2 * nslot) {
        f32x4 v0[8], v1[8]; tr_load<K, N>(W, gain, it, lane, v0);
        const bool two = it + nslot < NI;
        if (two) tr_load<K, N>(W, gain, it + nslot, lane, v1);
        tr_store<K, N>(WT, it, lane, v0);
        if (two) tr_store<K, N>(WT, it + nslot, lane, v1);
    }
    return (first + NI) % nslot;
}
template <int K, int N> __device__ __forceinline__ void quant_weights_i8(Frame& F, const float* W, const float* gain, signed char* W8, float* sw, LAS float* cm) {
    static_assert(K == 2048 && N % 32 == 0, "quant_weights_i8 geometry: K / 8 waves / 64 rows = 4 register chunks per wave");
    const int lane = F.lane, w = F.wave, g4 = lane >> 3, kb = lane & 7; constexpr int KW = K / NWAVES, NC = KW / 64;
    for (int it = F.vcu; it < N / 32; it += F.G) {
        const int n4 = 32 * it + 4 * g4;
        f32x4 v[NC][8];
#pragma unroll
        for (int c = 0; c < NC; ++c) { const int k8 = w * KW + 64 * c + 8 * kb; const float* src = W + (size_t)k8 * N + n4;
#pragma unroll
            for (int e = 0; e < 8; ++e) v[c][e] = *(const GAS f32x4*)(src + (size_t)e * N); }
        float m0 = 0.f, m1 = 0.f, m2 = 0.f, m3 = 0.f;
#pragma unroll
        for (int c = 0; c < NC; ++c) { const int k8 = w * KW + 64 * c + 8 * kb;
            f32x4 ga = {1.f, 1.f, 1.f, 1.f}, gb = ga; if (gain) { ga = *(const GAS f32x4*)(gain + k8); gb = *(const GAS f32x4*)(gain + k8 + 4); }
            v[c][0] = v[c][0] * ga.x; v[c][1] = v[c][1] * ga.y; v[c][2] = v[c][2] * ga.z; v[c][3] = v[c][3] * ga.w; v[c][4] = v[c][4] * gb.x; v[c][5] = v[c][5] * gb.y; v[c][6] = v[c][6] * gb.z; v[c][7] = v[c][7] * gb.w;
#pragma unroll
            for (int e = 0; e < 8; ++e) { m0 = fmaxf(m0, fabsf(v[c][e].x)); m1 = fmaxf(m1, fabsf(v[c][e].y)); m2 = fmaxf(m2, fabsf(v[c][e].z)); m3 = fmaxf(m3, fabsf(v[c][e].w)); } }
#pragma unroll
        for (int o = 1; o < 8; o <<= 1) { m0 = fmaxf(m0, __shfl_xor(m0, o)); m1 = fmaxf(m1, __shfl_xor(m1, o)); m2 = fmaxf(m2, __shfl_xor(m2, o)); m3 = fmaxf(m3, __shfl_xor(m3, o)); }
        __syncthreads();
        if (kb == 0) *(LAS f32x4*)(cm + w * 32 + 4 * g4) = (f32x4){m0, m1, m2, m3};
        __syncthreads();
        f32x4 cmax = *(const LAS f32x4*)(cm + 4 * g4);
#pragma unroll
        for (int ww = 1; ww < NWAVES; ++ww) { const f32x4 o = *(const LAS f32x4*)(cm + ww * 32 + 4 * g4); cmax.x = fmaxf(cmax.x, o.x); cmax.y = fmaxf(cmax.y, o.y); cmax.z = fmaxf(cmax.z, o.z); cmax.w = fmaxf(cmax.w, o.w); }
        const f32x4 inv = {cmax.x > 0.f ? 127.f / cmax.x : 0.f, cmax.y > 0.f ? 127.f / cmax.y : 0.f, cmax.z > 0.f ? 127.f / cmax.z : 0.f, cmax.w > 0.f ? 127.f / cmax.w : 0.f};
        if (w == 0 && kb == 0) *(GAS f32x4*)(sw + n4) = cmax * (1.0f / 127.0f);
#pragma unroll
        for (int c = 0; c < NC; ++c) { const int k8 = w * KW + 64 * c + 8 * kb;
            int q[4][8];
#pragma unroll
            for (int e = 0; e < 8; ++e) { const f32x4 t = v[c][e] * inv;
                q[0][e] = (int)__builtin_rintf(t.x); q[1][e] = (int)__builtin_rintf(t.y); q[2][e] = (int)__builtin_rintf(t.z); q[3][e] = (int)__builtin_rintf(t.w); }
#pragma unroll
            for (int j = 0; j < 4; ++j) { v2u o;
                o.x = (unsigned)(q[j][0] & 255) | ((unsigned)(q[j][1] & 255) << 8) | ((unsigned)(q[j][2] & 255) << 16) | ((unsigned)(q[j][3] & 255) << 24);
                o.y = (unsigned)(q[j][4] & 255) | ((unsigned)(q[j][5] & 255) << 8) | ((unsigned)(q[j][6] & 255) << 16) | ((unsigned)(q[j][7] & 255) << 24);
                *(GAS v2u*)(W8 + (size_t)(n4 + j) * K + k8) = o; } }
    }
    __syncthreads();
}
__device__ __forceinline__ void quant_panel_i8(Frame& F, const bf16* XBp, signed char* X8p, float* sxp, const unsigned long long* rowsq_p, const int row0, const int nrows) {
    const int lane = F.lane;
    for (int rb4 = 0; rb4 < nrows; rb4 += 4) {
        v4u a[4][2];
#pragma unroll
        for (int i = 0; i < 4; ++i) { const bf16* src = XBp + (size_t)(row0 + rb4 + i) * D + 32 * lane; a[i][0] = *(const GAS v4u*)src; a[i][1] = *(const GAS v4u*)(src + 8); }
        v4u b[4][2];
#pragma unroll
        for (int i = 0; i < 4; ++i) { const bf16* src = XBp + (size_t)(row0 + rb4 + i) * D + 32 * lane + 16; b[i][0] = *(const GAS v4u*)src; b[i][1] = *(const GAS v4u*)(src + 8); }
#pragma unroll
        for (int i = 0; i < 4; ++i) { const int r = row0 + rb4 + i;
            const unsigned wds[16] = {a[i][0].x, a[i][0].y, a[i][0].z, a[i][0].w, a[i][1].x, a[i][1].y, a[i][1].z, a[i][1].w, b[i][0].x, b[i][0].y, b[i][0].z, b[i][0].w, b[i][1].x, b[i][1].y, b[i][1].z, b[i][1].w};
            float mx = 0.f;
#pragma unroll
            for (int e = 0; e < 16; ++e) mx = fmaxf(mx, fmaxf(fabsf(bflo(wds[e])), fabsf(bfhi(wds[e]))));
#pragma unroll
            for (int o = 1; o < 64; o <<= 1) mx = fmaxf(mx, __shfl_xor(mx, o));
            const float inv = mx > 0.f ? 127.f / mx : 0.f, step = mx * (1.0f / 127.0f);
            unsigned qo[8];
#pragma unroll
            for (int e = 0; e < 8; ++e) { const int q0 = (int)__builtin_rintf(bflo(wds[2 * e]) * inv), q1 = (int)__builtin_rintf(bfhi(wds[2 * e]) * inv), q2 = (int)__builtin_rintf(bflo(wds[2 * e + 1]) * inv), q3 = (int)__builtin_rintf(bfhi(wds[2 * e + 1]) * inv);
                qo[e] = (unsigned)(q0 & 255) | ((unsigned)(q1 & 255) << 8) | ((unsigned)(q2 & 255) << 16) | ((unsigned)(q3 & 255) << 24); }
            signed char* dst = X8p + (size_t)r * D + 32 * lane;
            *(GAS v4u*)dst = (v4u){qo[0], qo[1], qo[2], qo[3]}; *(GAS v4u*)(dst + 16) = (v4u){qo[4], qo[5], qo[6], qo[7]};
            if (lane == 0) sxp[r] = rowsq_p ? __builtin_amdgcn_rsqf((float)rowsq_p[r] * (1.0f / (2048.0f * 16777216.0f)) + 1e-6f) * step : step; }
    }
}
template <bool HASY> __device__ __forceinline__ void quant_panel_f32(Frame& F, const float* Xp, const bf16* Yp, signed char* X8p, float* sxp, const int row0, const int nrows) {
    const int lane = F.lane;
    constexpr int RB = HASY ? 2 : 4;
    for (int rb = 0; rb < nrows; rb += RB) {
        f32x4 v[RB][8]; v4u yv[RB][4];
#pragma unroll
        for (int i = 0; i < RB; ++i) { const float* src = Xp + (size_t)(row0 + rb + i) * D + 8 * lane;
#pragma unroll
            for (int j = 0; j < 4; ++j) { v[i][2 * j] = *(const GAS f32x4*)(src + 512 * j); v[i][2 * j + 1] = *(const GAS f32x4*)(src + 512 * j + 4); }
            if constexpr (HASY) { const bf16* ys = Yp + (size_t)(row0 + rb + i) * D + 8 * lane;
#pragma unroll
                for (int j = 0; j < 4; ++j) yv[i][j] = *(const GAS v4u*)(ys + 512 * j); } }
#pragma unroll
        for (int i = 0; i < RB; ++i) { const int r = row0 + rb + i; float mx = 0.f, ss = 0.f;
            if constexpr (HASY) {
#pragma unroll
                for (int j = 0; j < 4; ++j) { const v4u w = yv[i][j]; v[i][2 * j] = v[i][2 * j] + (f32x4){bflo(w.x), bfhi(w.x), bflo(w.y), bfhi(w.y)}; v[i][2 * j + 1] = v[i][2 * j + 1] + (f32x4){bflo(w.z), bfhi(w.z), bflo(w.w), bfhi(w.w)}; } }
#pragma unroll
            for (int j = 0; j < 8; ++j) { const f32x4 t = v[i][j]; mx = fmaxf(fmaxf(mx, fmaxf(fabsf(t.x), fabsf(t.y))), fmaxf(fabsf(t.z), fabsf(t.w))); ss += (t.x * t.x + t.y * t.y) + (t.z * t.z + t.w * t.w); }
#pragma unroll
            for (int o = 1; o < 64; o <<= 1) mx = fmaxf(mx, __shfl_xor(mx, o));
            ss = wave_sum(ss);
            const float inv = mx > 0.f ? 127.f / mx : 0.f, step = mx * (1.0f / 127.0f);
            signed char* dst = X8p + (size_t)r * D + 8 * lane;
#pragma unroll
            for (int j = 0; j < 4; ++j) { const f32x4 t0 = v[i][2 * j] * inv, t1 = v[i][2 * j + 1] * inv;
                const int q0 = (int)__builtin_rintf(t0.x), q1 = (int)__builtin_rintf(t0.y), q2 = (int)__builtin_rintf(t0.z), q3 = (int)__builtin_rintf(t0.w), q4 = (int)__builtin_rintf(t1.x), q5 = (int)__builtin_rintf(t1.y), q6 = (int)__builtin_rintf(t1.z), q7 = (int)__builtin_rintf(t1.w);
                v2u o; o.x = (unsigned)(q0 & 255) | ((unsigned)(q1 & 255) << 8) | ((unsigned)(q2 & 255) << 16) | ((unsigned)(q3 & 255) << 24); o.y = (unsigned)(q4 & 255) | ((unsigned)(q5 & 255) << 8) | ((unsigned)(q6 & 255) << 16) | ((unsigned)(q7 & 255) << 24);
                *(GAS v2u*)(dst + 512 * j) = o; }
            if (lane == 0) sxp[r] = __builtin_amdgcn_rsqf(ss * (1.0f / 2048.0f) + 1e-6f) * step; }
    }
}
__device__ __forceinline__ int convert_win(const Args& a, unsigned char* ws, int l, int slot, int nslot, int lane, int f) {
    bf16* Win = (bf16*)(ws + WS_WIN);
    return convert_matrix<D, INC>(a.in[2] + (size_t)l * D * INC, a.in[1] + l * D, Win + (size_t)l * INC * D, slot, nslot, f, lane);
}
__device__ __forceinline__ int convert_rest(const Args& a, unsigned char* ws, int l, int slot, int nslot, int lane, int f) {
    bf16* Woab = (bf16*)(ws + WS_WOAB); bf16* Wout = (bf16*)(ws + WS_WOUT); bf16* W1 = (bf16*)(ws + WS_W1); bf16* W2 = (bf16*)(ws + WS_W2);
    f = convert_matrix<SBW, D>(a.in[9] + (size_t)l * SBW * D, nullptr, Woab + (size_t)l * 4096 * 1024, slot, nslot, f, lane);
    f = convert_matrix<SGW, D>(a.in[10] + (size_t)l * SGW * D, nullptr, Woab + (size_t)l * 4096 * 1024 + (size_t)2048 * 1024, slot, nslot, f, lane);
#if !I8_OUT
    f = convert_matrix<D, D>(a.in[11] + (size_t)l * D * D, nullptr, Wout + (size_t)l * D * D, slot, nslot, f, lane);
#endif
#if !I8_FF1
    f = convert_matrix<D, DFF>(a.in[13] + (size_t)l * D * DFF, a.in[12] + l * D, W1 + (size_t)l * DFF * D, slot, nslot, f, lane);
#endif
    f = convert_matrix<DFF, D>(a.in[14] + (size_t)l * DFF * D, nullptr, W2 + (size_t)l * D * DFF, slot, nslot, f, lane);
    return f;
}
__device__ __forceinline__ void convert_layer(const Args& a, unsigned char* ws, int l, int slot, int nslot, int lane) {
    int f = convert_rest(a, ws, l, slot, nslot, lane, 0);
#if !I8_INPROJ
    if (l + 1 < DEPTH) convert_win(a, ws, l + 1, slot, nslot, lane, f);
#endif
}
template <int L, int BASE> struct ConvSide {
    struct State { f32x4 v[8]; f32x4 g0, g1; bf16* dst; int K; };
    __device__ __forceinline__ void begin(int ord, int lane, State& st) const {
        constexpr int I_IN = (D / 64) * (INC / 32), I_OA = (SBW / 64) * (D / 32), I_OUT = (D / 64) * (D / 32), I_1 = (D / 64) * (DFF / 32), I_2 = (DFF / 64) * (D / 32);
        constexpr int I_LAYER = I_IN + 2 * I_OA + I_OUT + I_1 + I_2;
        const int G = (int)gridDim.x, bx = (int)blockIdx.x, vcu = (G % 8 == 0) ? (bx % 8) * (G / 8) + bx / 8 : bx;
        const int slot = vcu * NWAVES + __builtin_amdgcn_readfirstlane((int)(threadIdx.x >> 6)), nslot = G * NWAVES;
        int r = (slot + (BASE + ord) * nslot) % I_LAYER;
        const __attribute__((address_space(4))) Args* a = (const __attribute__((address_space(4))) Args*)__builtin_amdgcn_kernarg_segment_ptr();
        unsigned char* ws = a->ws;
        const float* W; const float* gain = nullptr; bf16* WT; int K, N, kq, nb;
        if (r < I_IN) { W = a->in[2] + (size_t)L * D * INC; gain = a->in[1] + L * D; WT = (bf16*)(ws + WS_WIN) + (size_t)L * INC * D; K = D; N = INC; kq = r / (INC / 32); nb = r % (INC / 32); }
        else if ((r -= I_IN) < I_1) { W = a->in[13] + (size_t)L * D * DFF; gain = a->in[12] + L * D; WT = (bf16*)(ws + WS_W1) + (size_t)L * DFF * D; K = D; N = DFF; kq = r / (DFF / 32); nb = r % (DFF / 32); }
        else if ((r -= I_1) < I_2) { W = a->in[14] + (size_t)L * DFF * D; WT = (bf16*)(ws + WS_W2) + (size_t)L * D * DFF; K = DFF; N = D; kq = r / (D / 32); nb = r % (D / 32); }
        else if ((r -= I_2) < I_OUT) { W = a->in[11] + (size_t)L * D * D; WT = (bf16*)(ws + WS_WOUT) + (size_t)L * D * D; K = D; N = D; kq = r / (D / 32); nb = r % (D / 32); }
        else if ((r -= I_OUT) < I_OA) { W = a->in[9] + (size_t)L * SBW * D; WT = (bf16*)(ws + WS_WOAB) + (size_t)L * 4096 * 1024; K = SBW; N = D; kq = r / (D / 32); nb = r % (D / 32); }
        else { r -= I_OA; W = a->in[10] + (size_t)L * SGW * D; WT = (bf16*)(ws + WS_WOAB) + (size_t)L * 4096 * 1024 + (size_t)2048 * 1024; K = SGW; N = D; kq = r / (D / 32); nb = r % (D / 32); }
        const int k8 = 64 * kq + 8 * (lane & 7), n4 = 32 * nb + 4 * (lane >> 3);
        const float* src = W + (size_t)k8 * N + n4;
#pragma unroll
        for (int e = 0; e < 8; ++e) st.v[e] = *(const GAS f32x4*)(src + (size_t)e * N);
        if (gain) { st.g0 = *(const GAS f32x4*)(gain + k8); st.g1 = *(const GAS f32x4*)(gain + k8 + 4); } else { st.g0 = (f32x4){1.f, 1.f, 1.f, 1.f}; st.g1 = st.g0; }
        st.dst = WT + (size_t)n4 * K + k8; st.K = K;
    }
    __device__ __forceinline__ void end(int lane, State& st) const {
        const f32x4 v0 = st.v[0] * st.g0.x, v1 = st.v[1] * st.g0.y, v2 = st.v[2] * st.g0.z, v3 = st.v[3] * st.g0.w, v4 = st.v[4] * st.g1.x, v5 = st.v[5] * st.g1.y, v6 = st.v[6] * st.g1.z, v7 = st.v[7] * st.g1.w;
#pragma unroll
        for (int j = 0; j < 4; ++j) { v4u o; o.x = pk2(v0[j], v1[j]); o.y = pk2(v2[j], v3[j]); o.z = pk2(v4[j], v5[j]); o.w = pk2(v6[j], v7[j]); *(GAS v4u*)(st.dst + (size_t)j * st.K) = o; }
    }
};
__device__ __forceinline__ void p0_prologue(Frame& F, const Args& a, unsigned char* ws) {
    const int gw = F.vcu * NWAVES + F.wave, NGW = F.G * NWAVES;
    bf16* Wsp = (bf16*)(ws + WS_WSP);
#if I8_INPROJ
    for (int l = 0; l < DEPTH; ++l) quant_weights_i8<D, INC>(F, a.in[2] + (size_t)l * D * INC, a.in[1] + l * D, (signed char*)(ws + WS_WIN8) + (size_t)l * INC * D, (float*)(ws + WS_SWIN) + l * INC, (LAS float*)(F.lds));
#if I8_OUT
    for (int l = 0; l < DEPTH; ++l) quant_weights_i8<D, D>(F, a.in[11] + (size_t)l * D * D, nullptr, (signed char*)(ws + WS_WOUT8) + (size_t)l * D * D, (float*)(ws + WS_SWOUT) + l * D, (LAS float*)(F.lds));
#endif
#if I8_FF1
    for (int l = 0; l < DEPTH; ++l) quant_weights_i8<D, DFF>(F, a.in[13] + (size_t)l * D * DFF, a.in[12] + l * D, (signed char*)(ws + WS_W18) + (size_t)l * DFF * D, (float*)(ws + WS_SW1) + l * DFF, (LAS float*)(F.lds));
#endif
#else
    convert_win(a, ws, 0, gw, NGW, F.lane, 0);
#endif
    { const float* wsrc = a.in[7]; const int n = DEPTH * NG * SL * SL;
      for (int e = (F.vcu * NWAVES * 64 + F.tid) * 2; e < n; e += F.G * NWAVES * 64 * 2) { const int i = (e >> 7) & 127, j = e & 127; const bool keep = (j >> 6) <= (i >> 6);
          const f32x2 v = *(const GAS f32x2*)(wsrc + e); *(GAS unsigned*)(Wsp + e) = keep ? pk2(v.x, v.y) : 0u; } }
    if (!I8_INPROJ) { const float* x = a.in[0]; bf16* XB = (bf16*)(ws + WS_XB); unsigned long long* RS0 = (unsigned long long*)(ws + WS_RS);
      for (int m = gw; m < M; m += NGW) { const GAS f32x4* xr = (const GAS f32x4*)(x + (size_t)m * D) + F.lane; GAS v2u* o = (GAS v2u*)(XB + (size_t)m * D) + F.lane; float ss = 0.f;
#pragma unroll
          for (int j = 0; j < 8; ++j) { const f32x4 v = xr[64 * j]; ss += (v.x * v.x + v.y * v.y) + (v.z * v.z + v.w * v.w); v2u w; w.x = pk2(v.x, v.y); w.y = pk2(v.z, v.w); o[64 * j] = w; }
          ss = wave_sum(ss); if (F.lane == 0) RS0[m] = (unsigned long long)(ss * 16777216.0f + 0.5f); } }
}

__device__ __forceinline__ void attn_naive(Frame& F, const bf16* proj, bf16* O, const float* gq, const float* gk) {
    const int gw = F.vcu * NWAVES + F.wave, NGW = F.G * NWAVES; const int lane = F.lane;
    for (int u = gw; u < M * NH; u += NGW) {
        const int h = u & 7, row = u >> 3, t = row & (SEQ - 1), rb = row - t;
        const float gq0 = gq[h * HD + 2 * lane], gq1 = gq[h * HD + 2 * lane + 1], gk0 = gk[h * HD + 2 * lane], gk1 = gk[h * HD + 2 * lane + 1];
        const unsigned qw = *(const GAS unsigned*)(proj + (size_t)row * INC + C_Q + h * HD + 2 * lane);
        float q0 = bflo(qw), q1 = bfhi(qw);
        const float rq = 1.0f / sqrtf(wave_sum(q0 * q0 + q1 * q1) * (1.0f / HD) + EPS);
        q0 = q0 * rq * gq0 * 0.08838834764831845f; q1 = q1 * rq * gq1 * 0.08838834764831845f;
        float carry = 0.f, o0 = 0.f, o1 = 0.f;
        for (int s = t - 1; s >= 0; --s) {
            const bf16* kr = proj + (size_t)(rb + s) * INC + h * HD + 2 * lane;
            const unsigned kw = *(const GAS unsigned*)(kr + C_K), vw = *(const GAS unsigned*)(kr + C_V);
            const float k0 = bflo(kw), k1 = bfhi(kw);
            const float rk = 1.0f / sqrtf(wave_sum(k0 * k0 + k1 * k1) * (1.0f / HD) + EPS);
            const float z = wave_sum(q0 * k0 * gk0 + q1 * k1 * gk1) * rk;
            const float sp = fmaxf(z, 0.f) + log1pf(expf(-fabsf(z)));
            const float a = expf(z - sp + carry);
            o0 += a * bflo(vw); o1 += a * bfhi(vw);
            carry -= sp;
            if (carry < SB_STOP) break;
        }
        *(GAS unsigned*)(O + (size_t)row * SBW + h * HD + 2 * lane) = pk2(o0, o1);
    }
}
__device__ __forceinline__ void sgu_naive(Frame& F, const bf16* proj, bf16* S, const bf16* Wsp, const float* lng, const float* lnb, const float* bsp) {
    LAS float* vn = (LAS float*)F.lds;
    LAS float* st = (LAS float*)(F.lds + 65536);
    for (int u = F.vcu; u < (M / SL) * NG; u += F.G) {
        const int g = u & 7, r0 = (u >> 3) * SL;
        __syncthreads();
        for (int rr = 0; rr < 16; ++rr) { const int j = F.wave * 16 + rr; const bf16* vr = proj + (size_t)(r0 + j) * INC + C_VS + 16 * F.lane;
            const v4u a = *(const GAS v4u*)vr, b = *(const GAS v4u*)(vr + 8); const unsigned w[8] = {a.x, a.y, a.z, a.w, b.x, b.y, b.z, b.w}; float s1 = 0.f, s2 = 0.f;
#pragma unroll
            for (int e = 0; e < 8; ++e) { const float lo = bflo(w[e]), hi = bfhi(w[e]); s1 += lo + hi; s2 += lo * lo + hi * hi; }
            s1 = wave_sum(s1); s2 = wave_sum(s2); const float mu = s1 * (1.0f / SGW), var = fmaxf(s2 * (1.0f / SGW) - mu * mu, 0.f);
            if (F.lane == 0) { st[2 * j] = mu; st[2 * j + 1] = 1.0f / sqrtf(var + EPS); } }
        __syncthreads();
        for (int e = F.tid; e < SL * GD; e += NWAVES * 64) { const int j = e >> 7, d = e & 127; const unsigned short raw = proj[(size_t)(r0 + j) * INC + C_VS + g * GD + d];
            vn[e] = (__uint_as_float((unsigned)raw << 16) - st[2 * j]) * st[2 * j + 1] * lng[g * GD + d] + lnb[g * GD + d]; }
        __syncthreads();
        const int d = F.tid & 127, iq = F.tid >> 7;
        for (int ii = 0; ii < 32; ++ii) { const int i = iq * 32 + ii; const bf16* wr_ = Wsp + ((size_t)g * SL + i) * SL; float acc = 0.f;
            for (int j = 0; j < SL; ++j) acc += __uint_as_float((unsigned)wr_[j] << 16) * vn[j * GD + d];
            const float uu = __uint_as_float((unsigned)proj[(size_t)(r0 + i) * INC + C_U + g * GD + d] << 16);
            S[(size_t)(r0 + i) * SGW + g * GD + d] = (bf16)f2bf(uu * (acc + bsp[g * SL + i])); }
    }
    __syncthreads();
}

#define MFMA32(a, b, c) __builtin_amdgcn_mfma_f32_32x32x16_bf16((a), (b), (c), 0, 0, 0)
__device__ __forceinline__ s16x4 tr16(const LAS unsigned char* p) { return __builtin_bit_cast(s16x4, __builtin_amdgcn_ds_read_tr16_b64_v4i16((LAS s16x4*)p)); }
__device__ __forceinline__ unsigned cvtpk(float lo, float hi) { typedef __bf16 bf2 __attribute__((ext_vector_type(2))); const f32x2 v = {lo, hi}; return __builtin_bit_cast(unsigned, __builtin_convertvector(v, bf2)); }
constexpr int ATT_GG = 4096, ATT_WV = 8832;
__device__ __forceinline__ void attn_mfma(Frame& F, const bf16* proj, bf16* O, const float* gq, const float* gk, const Args& args, unsigned char* ws, int conv_l) {
    LAS float* gg = (LAS float*)F.lds;
    for (int e = F.tid; e < NH * HD; e += NWAVES * 64) gg[e] = gq[e] * gk[e];
    __syncthreads();
    LAS unsigned char* wl = F.lds + ATT_GG + F.wave * ATT_WV; LAS float* rkl = (LAS float*)(wl + 8704);
    const int lane = F.lane, c = lane & 31, hh = lane >> 5;
    const int gw = F.vcu * NWAVES + F.wave, NGW = F.G * NWAVES;
    const LAS unsigned char* trb = wl + (4 * hh + ((lane & 15) >> 2)) * 272 + (16 * ((lane >> 4) & 1) + 4 * (lane & 3)) * 2;
    LAS unsigned char* vst = wl + (lane >> 4) * 272 + (lane & 15) * 16;
    constexpr float LOG2E = 1.4426950408889634f;
    if (conv_l >= 0 && (F.wave & 4)) convert_layer(args, ws, conv_l, gw, NGW, lane);
    const bool mloc = MIX_LOCAL && F.G == 256 && BATCH * NH * (SEQ / 32) == 2 * NGW;
    for (int u_ = gw; u_ < BATCH * NH * (SEQ / 32); u_ += NGW) {
        int u = u_;
        if (mloc) { const int i_ = u_ / NGW, v_ = (u_ % NGW) >> 3, w_ = u_ & 7, P_ = 8 * (v_ >> 5) + (v_ & 7), k_ = (v_ & 31) >> 3; u = ((P_ >> 5) * NH + 2 * k_ + i_) * (SEQ / 32) + ((P_ & 31) << 3) + w_; }
        const int qt = u & (SEQ / 32 - 1), bh = u / (SEQ / 32), h = bh & (NH - 1), b = bh / NH;
        const int q0 = qt * 32; const size_t rb = (size_t)b * SEQ;
        v4u kw[8], vw[8];
#define ATT_LOAD_KV(KT) do { const int k0_ = (KT) * 32; const bf16* krow_ = proj + (rb + k0_ + c) * INC + C_K + h * HD + 8 * hh; const bf16* vrow_ = proj + (rb + k0_ + (lane >> 4)) * INC + C_V + h * HD + 8 * (lane & 15); \
            _Pragma("unroll") for (int ks_ = 0; ks_ < 8; ++ks_) kw[ks_] = *(const GAS v4u*)(krow_ + 16 * ks_); \
            _Pragma("unroll") for (int i_ = 0; i_ < 8; ++i_) vw[i_] = *(const GAS v4u*)(vrow_ + (size_t)(4 * i_) * INC); } while (0)
        ATT_LOAD_KV(qt);
        bf16x8 qf[8]; float ssq = 0.f;
        { const bf16* qrow = proj + (rb + q0 + c) * INC + C_Q + h * HD + 8 * hh; const LAS float* gr = gg + h * HD + 8 * hh;
#pragma unroll
          for (int ks = 0; ks < 8; ++ks) { const v4u w = *(const GAS v4u*)(qrow + 16 * ks); const f32x4 g0 = *(const LAS f32x4*)(gr + 16 * ks), g1 = *(const LAS f32x4*)(gr + 16 * ks + 4);
              const float x0 = bflo(w.x), x1 = bfhi(w.x), x2 = bflo(w.y), x3 = bfhi(w.y), x4 = bflo(w.z), x5 = bfhi(w.z), x6 = bflo(w.w), x7 = bfhi(w.w);
              ssq += (x0 * x0 + x1 * x1) + (x2 * x2 + x3 * x3) + (x4 * x4 + x5 * x5) + (x6 * x6 + x7 * x7);
              v4u p; p.x = cvtpk(x0 * g0.x, x1 * g0.y); p.y = cvtpk(x2 * g0.z, x3 * g0.w); p.z = cvtpk(x4 * g1.x, x5 * g1.y); p.w = cvtpk(x6 * g1.z, x7 * g1.w);
              qf[ks] = __builtin_bit_cast(bf16x8, p); } }
        ssq += __shfl_xor(ssq, 32);
        const float cq = __builtin_amdgcn_rsqf(ssq * (1.0f / HD) + EPS) * (0.08838834764831845f * LOG2E);
        f32x16 o0, o1, o2, o3;
#pragma unroll
        for (int r = 0; r < 16; ++r) { o0[r] = 0.f; o1[r] = 0.f; o2[r] = 0.f; o3[r] = 0.f; }
        float carry = 0.f;
        for (int kt = qt; ; --kt) {
            bf16x8 kf[8]; float ksq = 0.f;
#pragma unroll
            for (int ks = 0; ks < 8; ++ks) { const v4u w = kw[ks]; kf[ks] = __builtin_bit_cast(bf16x8, w);
                const float x0 = bflo(w.x), x1 = bfhi(w.x), x2 = bflo(w.y), x3 = bfhi(w.y), x4 = bflo(w.z), x5 = bfhi(w.z), x6 = bflo(w.w), x7 = bfhi(w.w);
                ksq += (x0 * x0 + x1 * x1) + (x2 * x2 + x3 * x3) + (x4 * x4 + x5 * x5) + (x6 * x6 + x7 * x7); }
#pragma unroll
            for (int i = 0; i < 8; ++i) *(LAS v4u*)(vst + i * 4 * 272) = vw[i];
            { const int kn = kt > 0 ? kt - 1 : 0; ATT_LOAD_KV(kn); }
            ksq += __shfl_xor(ksq, 32);
            if (hh == 0) rkl[c] = __builtin_amdgcn_rsqf(ksq * (1.0f / HD) + EPS);
            f32x16 s;
#pragma unroll
            for (int r = 0; r < 16; ++r) s[r] = 0.f;
#pragma unroll
            for (int ks = 0; ks < 8; ++ks) s = MFMA32(kf[ks], qf[ks], s);
            asm volatile("s_waitcnt lgkmcnt(0)" ::: "memory");
            const bool diag = (kt == qt);
            float lk[16];
#pragma unroll
            for (int jj = 0; jj < 4; ++jj) { const f32x4 rk4 = *(const LAS f32x4*)(rkl + 4 * hh + 8 * jj);
#pragma unroll
                for (int i = 0; i < 4; ++i) { const int r = 4 * jj + i; const float z = s[r] * cq * rk4[i];
                    const float sp = fmaxf(z, 0.f) + __builtin_amdgcn_logf(1.0f + __builtin_amdgcn_exp2f(-fabsf(z)));
                    const bool dead = diag && (i + 8 * jj + 4 * hh >= c);
                    s[r] = z; lk[r] = dead ? 0.f : -sp; } }
            float G[4], Gp[4];
#pragma unroll
            for (int jj = 0; jj < 4; ++jj) { G[jj] = (lk[4 * jj] + lk[4 * jj + 1]) + (lk[4 * jj + 2] + lk[4 * jj + 3]); Gp[jj] = __shfl_xor(G[jj], 32); }
            const float T0 = G[0] + Gp[0], T1 = G[1] + Gp[1], T2 = G[2] + Gp[2], T3 = G[3] + Gp[3];
            float aft[4]; aft[3] = carry; aft[2] = carry + T3; aft[1] = aft[2] + T2; aft[0] = aft[1] + T1;
#pragma unroll
            for (int jj = 0; jj < 4; ++jj) { float t = aft[jj] + (hh == 0 ? Gp[jj] : 0.f);
#pragma unroll
                for (int i = 3; i >= 0; --i) { const int r = 4 * jj + i; const bool dead = diag && (i + 8 * jj + 4 * hh >= c);
                    const float l = lk[r]; s[r] = dead ? 0.f : __builtin_amdgcn_exp2f(s[r] + l + t); t += l; } }
            carry = aft[0] + T0;
            bf16x8 pf[2];
#pragma unroll
            for (int st = 0; st < 2; ++st) { v4u p; p.x = cvtpk(s[8 * st], s[8 * st + 1]); p.y = cvtpk(s[8 * st + 2], s[8 * st + 3]); p.z = cvtpk(s[8 * st + 4], s[8 * st + 5]); p.w = cvtpk(s[8 * st + 6], s[8 * st + 7]);
                pf[st] = __builtin_bit_cast(bf16x8, p); }
#pragma unroll
            for (int st = 0; st < 2; ++st) {
#define VFRAG(db) ({ const s16x4 lo_ = tr16(trb + (16 * st) * 272 + (db) * 64), hi_ = tr16(trb + (16 * st + 8) * 272 + (db) * 64); \
                     (bf16x8){lo_[0], lo_[1], lo_[2], lo_[3], hi_[0], hi_[1], hi_[2], hi_[3]}; })
                o0 = MFMA32(VFRAG(0), pf[st], o0); o1 = MFMA32(VFRAG(1), pf[st], o1); o2 = MFMA32(VFRAG(2), pf[st], o2); o3 = MFMA32(VFRAG(3), pf[st], o3);
#undef VFRAG
            }
            if (kt == 0 || __all(carry < SB_STOP * LOG2E)) break;
        }
#undef ATT_LOAD_KV
        bf16* orow = O + (rb + q0 + c) * SBW + h * HD + 4 * hh;
#pragma unroll
        for (int jj = 0; jj < 4; ++jj) {
            v2u w; w.x = cvtpk(o0[4 * jj], o0[4 * jj + 1]); w.y = cvtpk(o0[4 * jj + 2], o0[4 * jj + 3]); *(GAS v2u*)(orow + 8 * jj) = w;
            w.x = cvtpk(o1[4 * jj], o1[4 * jj + 1]); w.y = cvtpk(o1[4 * jj + 2], o1[4 * jj + 3]); *(GAS v2u*)(orow + 32 + 8 * jj) = w;
            w.x = cvtpk(o2[4 * jj], o2[4 * jj + 1]); w.y = cvtpk(o2[4 * jj + 2], o2[4 * jj + 3]); *(GAS v2u*)(orow + 64 + 8 * jj) = w;
            w.x = cvtpk(o3[4 * jj], o3[4 * jj + 1]); w.y = cvtpk(o3[4 * jj + 2], o3[4 * jj + 3]); *(GAS v2u*)(orow + 96 + 8 * jj) = w; }
    }
    if (conv_l >= 0 && !(F.wave & 4)) convert_layer(args, ws, conv_l, gw, NGW, lane);
    __syncthreads();
}

constexpr int SGU_ST = 0, SGU_IMG = 1024, SGU_IMG_BYTES = 128 * 272;
__device__ __forceinline__ void sgu_mfma(Frame& F, const bf16* proj, bf16* S, const bf16* Wsp, const float* lng, const float* lnb, const float* bsp) {
    LAS f32x2* st = (LAS f32x2*)(F.lds + SGU_ST); LAS unsigned char* img = F.lds + SGU_IMG;
    const int lane = F.lane, c = lane & 31, hh = lane >> 5, w = F.wave;
    const int dblk = w & 3, ih = w >> 2;
    const LAS unsigned char* trb = img + (8 * hh + ((lane & 15) >> 2)) * 272 + (32 * dblk + 16 * ((lane >> 4) & 1) + 4 * (lane & 3)) * 2;
    for (int u_ = F.vcu; u_ < (M / SL) * 2; u_ += F.G) {
        int u = u_;
        if (MIX_LOCAL && F.G == 256) u = 4 * (8 * (u_ >> 5) + (u_ & 7)) + ((u_ & 31) >> 3);
        const int r0 = (u >> 1) * SL, g0 = (u & 1) * 4;
        __syncthreads();
        { v4u ra[16], rb2[16];
#pragma unroll
          for (int rr = 0; rr < 16; ++rr) { const bf16* vr = proj + (size_t)(r0 + w * 16 + rr) * INC + C_VS + 16 * lane; ra[rr] = *(const GAS v4u*)vr; rb2[rr] = *(const GAS v4u*)(vr + 8); }
#pragma unroll
          for (int rr = 0; rr < 16; ++rr) { const v4u a = ra[rr], b = rb2[rr];
              float s1 = ((bflo(a.x) + bfhi(a.x)) + (bflo(a.y) + bfhi(a.y))) + ((bflo(a.z) + bfhi(a.z)) + (bflo(a.w) + bfhi(a.w))) + ((bflo(b.x) + bfhi(b.x)) + (bflo(b.y) + bfhi(b.y))) + ((bflo(b.z) + bfhi(b.z)) + (bflo(b.w) + bfhi(b.w)));
              s1 = wave_sum(s1); const float mu = s1 * (1.0f / SGW);
              float s2 = 0.f;
#define SQ_(x) { const float d0_ = bflo(x) - mu, d1_ = bfhi(x) - mu; s2 += d0_ * d0_ + d1_ * d1_; }
              SQ_(a.x) SQ_(a.y) SQ_(a.z) SQ_(a.w) SQ_(b.x) SQ_(b.y) SQ_(b.z) SQ_(b.w)
#undef SQ_
              s2 = wave_sum(s2);
              if (lane == 0) st[w * 16 + rr] = (f32x2){mu, 1.0f / sqrtf(s2 * (1.0f / SGW) + EPS)}; } }
        __syncthreads();
        v4u vx[4];
#define SGU_LOAD_V(G) do { _Pragma("unroll") for (int i_ = 0; i_ < 4; ++i_) vx[i_] = *(const GAS v4u*)(proj + (size_t)(r0 + w * 16 + 4 * i_ + (lane >> 4)) * INC + C_VS + (G) * GD + 8 * (lane & 15)); } while (0)
        SGU_LOAD_V(g0);
        v4u bw[2][8];
#define SGU_LOAD_W(G) do { _Pragma("unroll") for (int it_ = 0; it_ < 2; ++it_) _Pragma("unroll") for (int s_ = 0; s_ < 8; ++s_) bw[it_][s_] = *(const GAS v4u*)(Wsp + ((size_t)(G) * SL + 64 * ih + 32 * it_ + c) * SL + 16 * s_ + 8 * hh); } while (0)
        SGU_LOAD_W(g0);
        f32x4 lg0, lg1, lb0, lb1;
#define SGU_LOAD_LN(G) do { const int ch_ = lane & 15; lg0 = *(const GAS f32x4*)(lng + (G) * GD + 8 * ch_); lg1 = *(const GAS f32x4*)(lng + (G) * GD + 8 * ch_ + 4); lb0 = *(const GAS f32x4*)(lnb + (G) * GD + 8 * ch_); lb1 = *(const GAS f32x4*)(lnb + (G) * GD + 8 * ch_ + 4); } while (0)
        SGU_LOAD_LN(g0);
#pragma unroll 1
        for (int gi = 0; gi < 4; ++gi) {
            const int g = g0 + gi; LAS unsigned char* im = img + (gi & 1) * SGU_IMG_BYTES;
            v2u uw[2][4]; float bias2[2];
#pragma unroll
            for (int it = 0; it < 2; ++it) { bias2[it] = bsp[g * SL + 64 * ih + 32 * it + c];
#pragma unroll
                for (int jj = 0; jj < 4; ++jj) uw[it][jj] = *(const GAS v2u*)(proj + (size_t)(r0 + 64 * ih + 32 * it + c) * INC + C_U + g * GD + 32 * dblk + 4 * hh + 8 * jj); }
            { const int ch = lane & 15;
#pragma unroll
              for (int i = 0; i < 4; ++i) { const int j = w * 16 + 4 * i + (lane >> 4); const v4u x = vx[i]; const f32x2 ms = st[j];
                  const float m_ = ms.x, r_ = ms.y;
                  v4u p; p.x = cvtpk((bflo(x.x) - m_) * r_ * lg0.x + lb0.x, (bfhi(x.x) - m_) * r_ * lg0.y + lb0.y); p.y = cvtpk((bflo(x.y) - m_) * r_ * lg0.z + lb0.z, (bfhi(x.y) - m_) * r_ * lg0.w + lb0.w);
                  p.z = cvtpk((bflo(x.z) - m_) * r_ * lg1.x + lb1.x, (bfhi(x.z) - m_) * r_ * lg1.y + lb1.y); p.w = cvtpk((bflo(x.w) - m_) * r_ * lg1.z + lb1.z, (bfhi(x.w) - m_) * r_ * lg1.w + lb1.w);
                  *(LAS v4u*)(im + j * 272 + ch * 16) = p; } }
            if (gi < 3) { SGU_LOAD_V(g + 1); SGU_LOAD_LN(g + 1); }
            __syncthreads();
            const LAS unsigned char* tb = trb + (gi & 1) * SGU_IMG_BYTES;
            f32x16 acc0, acc1;
#pragma unroll
            for (int r = 0; r < 16; ++r) { acc0[r] = 0.f; acc1[r] = 0.f; }
#pragma unroll
            for (int s = 0; s < 8; ++s) { const s16x4 lo_ = tr16(tb + (16 * s) * 272), hi_ = tr16(tb + (16 * s + 4) * 272);
                const bf16x8 af = (bf16x8){lo_[0], lo_[1], lo_[2], lo_[3], hi_[0], hi_[1], hi_[2], hi_[3]};
                acc0 = MFMA32(af, __builtin_bit_cast(bf16x8, bw[0][s]), acc0); acc1 = MFMA32(af, __builtin_bit_cast(bf16x8, bw[1][s]), acc1); }
            if (gi < 3) SGU_LOAD_W(g + 1);
#pragma unroll
            for (int it = 0; it < 2; ++it) { const int i = 64 * ih + 32 * it + c; const float bias = bias2[it];
                bf16* sp = S + (size_t)(r0 + i) * SGW + g * GD + 32 * dblk + 4 * hh;
#pragma unroll
                for (int jj = 0; jj < 4; ++jj) { const v2u u2 = uw[it][jj];
                    const float m0 = (it == 0 ? acc0[4 * jj] : acc1[4 * jj]) + bias, m1 = (it == 0 ? acc0[4 * jj + 1] : acc1[4 * jj + 1]) + bias, m2 = (it == 0 ? acc0[4 * jj + 2] : acc1[4 * jj + 2]) + bias, m3 = (it == 0 ? acc0[4 * jj + 3] : acc1[4 * jj + 3]) + bias;
                    v2u o; o.x = cvtpk(bflo(u2.x) * m0, bfhi(u2.x) * m1); o.y = cvtpk(bflo(u2.y) * m2, bfhi(u2.y) * m3); *(GAS v2u*)(sp + 8 * jj) = o; } }
        }
#undef SGU_LOAD_V
#undef SGU_LOAD_W
#undef SGU_LOAD_LN
    }
    __syncthreads();
}

constexpr int N_PHASES = 1 + 6 * DEPTH;
#ifndef MIX_IMPL
#define MIX_IMPL 2
#endif
#ifndef PROBE_DUP
#define PROBE_DUP -1
#endif
#ifndef MK_PER_PHASE
#define MK_PER_PHASE 0
#endif


#ifndef STAGGER_SLEEP
#define STAGGER_SLEEP 0
#endif
__device__ __forceinline__ void phase_stagger() {
    if (STAGGER_SLEEP > 0) { const int g = __builtin_amdgcn_readfirstlane((int)((blockIdx.x >> 3) & 3u)); for (int i = 0; i < g; ++i) __builtin_amdgcn_s_sleep(STAGGER_SLEEP); }
}


#ifndef GEMM_KROT
#define GEMM_KROT 1
#endif
#define KROT(K) (GEMM_KROT ? (int)(blockIdx.x % 8u) * ((K) / 64 / 8) : 0)
#ifndef INPROJ_SPLIT
#define INPROJ_SPLIT 0
#endif
#ifndef CONV_IN_MIX
#define CONV_IN_MIX 1
#endif
template <bool ON, int L, int BASE> struct SideSel { typedef ConvSide<L, BASE> T; };
template <int L, int BASE> struct SideSel<false, L, BASE> { typedef pg8::NoSide T; };
constexpr int RS_TAB_OFF = RING_BYTES;
template <class Sched> __device__ __forceinline__ int build_rs_tab(Frame& F, const Sched& S, const unsigned long long* rowsq) {
    pg8::Unit u0; int pm = -1; if (S.next(0, u0)) pm = u0.pm;
    for (int i = 1; S.next(i, u0); ++i) if (u0.pm != pm) pm = -2;
    __syncthreads();
    if (pm >= 0 && F.tid < 256) ((LAS float*)(F.lds + RS_TAB_OFF))[F.tid] = pg8::rs_of(rowsq[(size_t)pm * 256 + F.tid]);
    __syncthreads();
    return pm;
}

constexpr int SW_TAB_OFF = RS_TAB_OFF + 1024, SW_TAB_UNITS = 9;
template <class Sched> __device__ __forceinline__ void build_sw_tab(Frame& F, const Sched& S, const float* sw, int pn_off) {
    pg8::Unit u_;
    for (int i = 0; i < SW_TAB_UNITS && S.next(i, u_); ++i)
        if (F.tid < 256) ((LAS float*)(F.lds + SW_TAB_OFF))[i * 256 + F.tid] = sw[(size_t)(u_.pn + pn_off) * 256 + F.tid];
}

constexpr bool NEED_XB = !(I8_INPROJ && I8_FF1 && !I8_OUT);
constexpr int CW_PANEL = 786432;
template <class Sched> __device__ __forceinline__ void panel_group(Frame& F, const Sched& S, int pmt, int& rank, int& n) {
    volatile LAS int* sc = (volatile LAS int*)(F.lds + RS_TAB_OFF);
    bool same = false;
    if (F.tid < F.G) { Sched S2 = S; S2.c = F.tid; pg8::Unit u_; same = S2.next(0, u_) && u_.pm == pmt; }
    const unsigned long long b0 = __ballot(same), b1 = __ballot(same && F.tid < S.c);
    if (F.lane == 0) { sc[F.wave] = __popcll(b0); sc[NWAVES + F.wave] = __popcll(b1); }
    __syncthreads();
    int nn = 0, rr = 0;
#pragma unroll
    for (int w = 0; w < NWAVES; ++w) { nn += sc[w]; rr += sc[NWAVES + w]; }
    n = __builtin_amdgcn_readfirstlane(nn); rank = __builtin_amdgcn_readfirstlane(rr);
    if (F.G > NWAVES * 64 || pmt < 0 || (n != 1 && n != 2 && n != 4 && n != 8)) { n = 1; rank = 0; }
    __syncthreads();
}
__device__ __forceinline__ void panel_barrier(unsigned* cnt, unsigned n, unsigned* bar) {
    asm volatile("s_waitcnt vmcnt(0)" ::: "memory");
    __syncthreads();
    if (threadIdx.x == 0) {
        __builtin_amdgcn_fence(__ATOMIC_RELEASE, "agent");
        asm volatile("s_waitcnt vmcnt(0)" ::: "memory");
        (void)xb_add(cnt, 1u);
        XB_SPIN(xb_ld(cnt) < n, bar);
        __builtin_amdgcn_fence(__ATOMIC_ACQUIRE, "agent");
        asm volatile("s_waitcnt vmcnt(0)" ::: "memory");
    }
    __syncthreads();
}
template <class Sched> __device__ __forceinline__ void quant_coop(Frame& F, const Sched& S, int pmt, const bf16* XBp, const float* Xf, const bf16* Yp, signed char* X8p, float* sxp, const unsigned long long* rowsq_p, unsigned* cnt, unsigned* bar,
                                                      const float* Xf2 = nullptr, const bf16* Yp2 = nullptr, signed char* X8p2 = nullptr, float* sxp2 = nullptr) {
    int rank, n; panel_group(F, S, pmt, rank, n);
    if (pmt >= 0) {
        const int per = 256 / n, nr = per / NWAVES, row0 = rank * per + F.wave * nr;
        if (Xf && Yp) quant_panel_f32<true>(F, Xf, Yp, X8p, sxp, row0, nr); else if (Xf) quant_panel_f32<false>(F, Xf, nullptr, X8p, sxp, row0, nr); else quant_panel_i8(F, XBp, X8p, sxp, rowsq_p, row0, nr);
        if (Xf2) quant_panel_f32<true>(F, Xf2, Yp2, X8p2, sxp2, row0, nr);
        panel_barrier(cnt, (unsigned)n, bar);
        if (F.tid < 256) ((LAS float*)(F.lds + RS_TAB_OFF))[F.tid] = sxp[F.tid];
    }
    asm volatile("s_waitcnt vmcnt(0) lgkmcnt(0)" ::: "memory"); __syncthreads();
}
__device__ __forceinline__ void tab_from_sx(Frame& F, const float* sxp) {
    __syncthreads();
    if (F.tid < 256) ((LAS float*)(F.lds + RS_TAB_OFF))[F.tid] = sxp[F.tid];
    asm volatile("s_waitcnt vmcnt(0) lgkmcnt(0)" ::: "memory"); __syncthreads();
}
#ifndef DEFER_RES
#define DEFER_RES 1
#endif
#ifndef QUANT_BOTH
#define QUANT_BOTH 1
#endif
#ifndef DATAFLOW
#define DATAFLOW 1
#endif
#define PCNT(k, P) ((unsigned*)(F.ctl + CW_PANEL) + ((l * 8 + (k)) * 64 + (P)) * 16)
#define IN(k) (lo <= (k) && (k) < hi)
#define SEAM(k) do { if (IN(k) && IN((k) + 1)) { xcd_barrier(bar); if (PROBE_DUP == 30) xcd_barrier(bar); } } while (0)
template <int l> __device__ __forceinline__ void run_layer(Frame& F, const Args& args, unsigned char* ws, const XcdBarrier& bar, const int lo, const int hi) {
    constexpr int CONV_L = (l + 1 < DEPTH) ? l + 1 : -1;
    bf16* XB = (bf16*)(ws + WS_XB); bf16* PROJ = (bf16*)(ws + WS_PROJ); bf16* HID = (bf16*)(ws + WS_PROJ); bf16* OS = (bf16*)(ws + WS_OS); float* T = (float*)(ws + WS_T); bf16* MG = (bf16*)(ws + WS_MG);
    unsigned long long* RS = (unsigned long long*)(ws + WS_RS);
    bf16* YB = (bf16*)(ws + WS_XB);
    static_assert(!QUANT_BOTH || DEFER_RES, "QUANT_BOTH needs DEFER_RES");
    static_assert(!DEFER_RES || (!NEED_XB && FFN_SPLIT && I8_FF1 && !I8_OUT), "DEFER_RES needs the int8 in-projection and FFN-up paths");

        const int p = 1 + 6 * l;
        const bf16* Win = (const bf16*)(ws + WS_WIN) + (size_t)l * INC * D; const bf16* Woab = (const bf16*)(ws + WS_WOAB) + (size_t)l * 4096 * 1024; const bf16* Wout = (const bf16*)(ws + WS_WOUT) + (size_t)l * D * D;
        const bf16* W1 = (const bf16*)(ws + WS_W1) + (size_t)l * DFF * D; const bf16* W2 = (const bf16*)(ws + WS_W2) + (size_t)l * D * DFF; const bf16* Wsp = (const bf16*)(ws + WS_WSP) + (size_t)l * NG * SL * SL;
#if I8_INPROJ
#define INPROJ_GEMM(PN0, NT) do { \
            pg8::Gemm g{(const bf16*)(ws + WS_XB8), (const bf16*)(ws + WS_WIN8 + (size_t)l * INC * D + (size_t)(PN0) * 256 * D), M, (NT) * 256, D / 2, KROT(D / 2)}; pg8::StaticOrder S; S.init(M, (NT) * 256, F.G, (int)blockIdx.x); \
            pg8::Unit u0_; const int pmt = S.next(0, u0_) ? u0_.pm : -1;     \
            __syncthreads(); \
            build_sw_tab(F, S, (const float*)(ws + WS_SWIN) + l * INC, (PN0)); \
            quant_coop(F, S, pmt, XB + (size_t)pmt * 256 * D, l == 0 ? args.in[0] + (size_t)pmt * 256 * D : (NEED_XB ? (const float*)nullptr : (const float*)args.out + (size_t)pmt * 256 * D), (const bf16*)nullptr, (signed char*)(ws + WS_XB8) + (size_t)pmt * 256 * D, (float*)(ws + WS_SX) + pmt * 256, RS + (size_t)(2 * l) * M + pmt * 256, \
                       PCNT(0, pmt), bar.bar); \
            typedef pg8::NoSide SideT; \
            pg8::EpiIn<true, SideT, true> E{PROJ, RS + (size_t)(2 * l) * M, INC, (const LAS float*)(F.lds + RS_TAB_OFF), pmt, SideT{}, (PN0), (const LAS float*)(F.lds + SW_TAB_OFF), ws + WS_G8}; \
            pg8::gemm_phase<pg8::EpiIn<true, SideT, true>, pg8::StaticOrder, GP_ALIGN, GP_SP2, 1>(F.lds + RING_OFF, g, S, E); } while (0)
#else
#define INPROJ_GEMM(PN0, NT) do { \
            pg8::Gemm g{XB, Win + (size_t)(PN0) * 256 * D, M, (NT) * 256, D, KROT(D)}; pg8::StaticOrder S; S.init(M, (NT) * 256, F.G, (int)blockIdx.x); \
            const int pmt = build_rs_tab(F, S, RS + (size_t)(2 * l) * M); \
            typedef pg8::NoSide SideT; \
            pg8::EpiIn<true, SideT> E{PROJ, RS + (size_t)(2 * l) * M, INC, (const LAS float*)(F.lds + RS_TAB_OFF), pmt, SideT{}, (PN0), nullptr}; pg8::EpiIn<false, SideT> EG{PROJ, RS + (size_t)(2 * l) * M, INC, nullptr, pmt, SideT{}, (PN0), nullptr}; \
            if (pmt >= 0) pg8::gemm_phase<pg8::EpiIn<true, SideT>, pg8::StaticOrder, GP_ALIGN, GP_SP2>(F.lds + RING_OFF, g, S, E); \
            else if (pmt == -2) pg8::gemm_phase<pg8::EpiIn<false, SideT>, pg8::StaticOrder, GP_ALIGN, GP_SP2>(F.lds + RING_OFF, g, S, EG); } while (0)
#endif
        if (IN(p)) {
            if (INPROJ_SPLIT) INPROJ_GEMM(0, 20); else INPROJ_GEMM(0, 36);
            if (PROBE_DUP == 11 || PROBE_DUP == 13) { pg8::Gemm g{XB, Win, M, INC, D, KROT(D)}; pg8::StaticOrder S; S.init(M, INC, F.G, (int)blockIdx.x); pg8::EpiNull EN{args.out};
                if (PROBE_DUP == 11) pg8::gemm_phase<pg8::EpiNull, pg8::StaticOrder, GP_ALIGN, GP_SP2, 0>(F.lds + RING_OFF, g, S, EN); else pg8::gemm_phase<pg8::EpiNull, pg8::StaticOrder, GP_ALIGN, GP_SP2, 1>(F.lds + RING_OFF, g, S, EN); }
            SEAM(p);
        }
        if (IN(p + 1)) {
#if MIX_IMPL >= 1
            attn_mfma(F, PROJ, OS, args.in[3] + l * SBW, args.in[4] + l * SBW, args, ws, CONV_IN_MIX ? l : -1);
#else
            attn_naive(F, PROJ, OS, args.in[3] + l * SBW, args.in[4] + l * SBW);
#endif
#if MIX_IMPL >= 2
            sgu_mfma(F, PROJ, OS + (size_t)M * SBW, Wsp, args.in[5] + l * SGW, args.in[6] + l * SGW, args.in[8] + l * NG * SL);
#else
            sgu_naive(F, PROJ, OS + (size_t)M * SBW, Wsp, args.in[5] + l * SGW, args.in[6] + l * SGW, args.in[8] + l * NG * SL);
#endif
            if (PROBE_DUP == 2 || PROBE_DUP == 21) attn_mfma(F, PROJ, OS, args.in[3] + l * SBW, args.in[4] + l * SBW, args, ws, CONV_IN_MIX ? l : -1);
            if (PROBE_DUP == 2 || PROBE_DUP == 22) sgu_mfma(F, PROJ, OS + (size_t)M * SBW, Wsp, args.in[5] + l * SGW, args.in[6] + l * SGW, args.in[8] + l * NG * SL);
            if (INPROJ_SPLIT) INPROJ_GEMM(20, 16);
            SEAM(p + 1);
        }
        if (IN(p + 2)) {
            phase_stagger();
            pg8::Gemm g{OS, Woab, 2 * M, 4096, 1024, KROT(1024)}; pg8::YabOrder S; S.init(M, D, F.G, (int)blockIdx.x);
            pg8::EpiYab E{PROJ, MG, INC, C_GA, C_GB, D, M / 256, D / 256, ws + WS_G8};
            pg8::gemm_phase<pg8::EpiYab, pg8::YabOrder, GP_ALIGN, GP_SP2>(F.lds + RING_OFF, g, S, E);
            if (PROBE_DUP == 3) pg8::gemm_phase<pg8::EpiYab, pg8::YabOrder, GP_ALIGN, GP_SP2>(F.lds + RING_OFF, g, S, E);
            if (IN(p + 2) && IN(p + 3)) { pg8::Unit u0_; S.next(0, u0_); if (DATAFLOW && F.G == 256) panel_barrier(PCNT(3, u0_.pm), (unsigned)(F.G / (M / 256)), bar.bar); else xcd_barrier(bar); }
        }
        if (IN(p + 3)) {
#if I8_OUT
            pg8::Gemm g{(const bf16*)(ws + WS_XB8), (const bf16*)(ws + WS_WOUT8 + (size_t)l * D * D), M, D, D / 2, KROT(D / 2)}; pg8::StaticOrder S; S.init(M, D, F.G, (int)blockIdx.x);
            pg8::Unit u0_; const int pmt = S.next(0, u0_) ? u0_.pm : -1;
            __syncthreads();
            if (pmt >= 0) quant_panel_i8(F, MG + (size_t)pmt * 256 * D, (signed char*)(ws + WS_XB8) + (size_t)pmt * 256 * D, (float*)(ws + WS_SX) + pmt * 256, nullptr, F.wave * 32, 32);
            asm volatile("s_waitcnt vmcnt(0) lgkmcnt(0)" ::: "memory"); __syncthreads();
            if (pmt >= 0 && F.tid < 256) ((LAS float*)(F.lds + RS_TAB_OFF))[F.tid] = ((const float*)(ws + WS_SX))[pmt * 256 + F.tid];
            __syncthreads();
            pg8::EpiRes<true> E{l == 0 ? args.in[0] : (const float*)args.out, args.out, XB, RS + (size_t)(2 * l + 1) * M, D, (const LAS float*)(F.lds + RS_TAB_OFF), (const float*)(ws + WS_SWOUT) + l * D};
            pg8::gemm_phase<pg8::EpiRes<true>, pg8::StaticOrder, GP_ALIGN, GP_SP2, 1>(F.lds + RING_OFF, g, S, E);
#else
            pg8::Gemm g{MG, Wout, M, D, D, KROT(D)}; pg8::StaticOrder S; S.init(M, D, F.G, (int)blockIdx.x);
#if DEFER_RES
            pg8::EpiBf E{YB, D};
            pg8::gemm_phase<pg8::EpiBf, pg8::StaticOrder, GP_ALIGN, GP_SP2>(F.lds + RING_OFF, g, S, E);
#else
            pg8::EpiRes<false, NEED_XB> E{l == 0 ? args.in[0] : (const float*)args.out, args.out, XB, RS + (size_t)(2 * l + 1) * M, D, nullptr, nullptr};
            pg8::gemm_phase<pg8::EpiRes<false, NEED_XB>, pg8::StaticOrder, GP_ALIGN, GP_SP2>(F.lds + RING_OFF, g, S, E);
#endif
#endif
            SEAM(p + 3);
        }
#if FFN_SPLIT
        if (IN(p + 4)) {
            static_assert(I8_FF1 && QUANT_BOTH && DEFER_RES, "the FFN block's global-panel form (FfnOrder) is written for the int8 FFN-up path with one quantisation pass");
            { constexpr int hf = 0;
                const size_t r0 = 0;
                int pmf = 0;
#if I8_FF1
                { pg8::Gemm g{(const bf16*)(ws + WS_XB8 + r0 * D), (const bf16*)(ws + WS_W18 + (size_t)l * DFF * D), M, DFF, D / 2, KROT(D / 2)}; pg8::FfnOrder S; S.init(M / 2, DFF, F.G, (int)blockIdx.x, hf);
                  pg8::Unit u0_; const int pmt = S.next(0, u0_) ? u0_.pm : -1; pmf = pmt;
                  __syncthreads();
                  build_sw_tab(F, S, (const float*)(ws + WS_SW1) + l * DFF, 0);
#if QUANT_BOTH
                  { const size_t r1 = (size_t)S.partner(pmt) * 256;
                  quant_coop(F, S, pmt, XB + (r0 + (size_t)pmt * 256) * D, (DEFER_RES && l == 0 ? args.in[0] : (const float*)args.out) + (r0 + (size_t)pmt * 256) * D, YB + (r0 + (size_t)pmt * 256) * D, (signed char*)(ws + WS_XB8) + (r0 + (size_t)pmt * 256) * D, (float*)(ws + WS_SX) + r0 + pmt * 256, RS + (size_t)(2 * l + 1) * M + r0 + pmt * 256,
                             PCNT(1 + hf, pmt), bar.bar, (DEFER_RES && l == 0 ? args.in[0] : (const float*)args.out) + r1 * D, YB + r1 * D, (signed char*)(ws + WS_XB8) + r1 * D, (float*)(ws + WS_SX) + r1); }
#else
                  quant_coop(F, S, pmt, XB + (r0 + (size_t)pmt * 256) * D, NEED_XB ? (const float*)nullptr : (DEFER_RES && l == 0 ? args.in[0] : (const float*)args.out) + (r0 + (size_t)pmt * 256) * D, DEFER_RES ? YB + (r0 + (size_t)pmt * 256) * D : (const bf16*)nullptr, (signed char*)(ws + WS_XB8) + (r0 + (size_t)pmt * 256) * D, (float*)(ws + WS_SX) + r0 + pmt * 256, RS + (size_t)(2 * l + 1) * M + r0 + pmt * 256,
                             PCNT(1 + hf, pmt), bar.bar);
#endif
                  pg8::EpiFF1<true, pg8::NoSide, true> E8{HID + r0 * DFF, RS + (size_t)(2 * l + 1) * M + r0, DFF, (const LAS float*)(F.lds + RS_TAB_OFF), pmt, pg8::NoSide{}, (const LAS float*)(F.lds + SW_TAB_OFF)};
                  pg8::gemm_phase<pg8::EpiFF1<true, pg8::NoSide, true>, pg8::FfnOrder, GP_ALIGN, GP_SP2, 1>(F.lds + RING_OFF, g, S, E8); }
#else
                { pg8::Gemm g{XB + r0 * D, W1, M / 2, DFF, D, KROT(D)}; pg8::StaticOrder S; S.init(M / 2, DFF, F.G, (int)blockIdx.x);
                  const int pmt = build_rs_tab(F, S, RS + (size_t)(2 * l + 1) * M + r0);
                  typedef typename SideSel<(CONV_L >= 0) && !CONV_IN_MIX, (CONV_L >= 0 ? CONV_L : 0), 9 + 4 * hf>::T SideT; const SideT side{};
                  pg8::EpiFF1<true, SideT> E{HID + r0 * DFF, RS + (size_t)(2 * l + 1) * M + r0, DFF, (const LAS float*)(F.lds + RS_TAB_OFF), pmt, side, nullptr}; pg8::EpiFF1<false, SideT> EG{HID + r0 * DFF, RS + (size_t)(2 * l + 1) * M + r0, DFF, nullptr, pmt, side, nullptr};
                  if (pmt >= 0) pg8::gemm_phase<pg8::EpiFF1<true, SideT>, pg8::StaticOrder, GP_ALIGN, GP_SP2>(F.lds + RING_OFF, g, S, E);
                  else if (pmt == -2) pg8::gemm_phase<pg8::EpiFF1<false, SideT>, pg8::StaticOrder, GP_ALIGN, GP_SP2>(F.lds + RING_OFF, g, S, EG); }
#endif
                if (DATAFLOW && I8_FF1 && F.G == 256) panel_barrier(PCNT(4 + hf, pmf), (unsigned)(F.G / (M / 2 / 256)), bar.bar); else xcd_barrier(bar);
                { pg8::Gemm g{HID + r0 * DFF, W2, M, D, DFF, KROT(DFF)}; pg8::FfnOrder S; S.init(M / 2, D, F.G, (int)blockIdx.x, hf);
                  pg8::EpiRes<false, NEED_XB, DEFER_RES> E{(DEFER_RES && l == 0 ? args.in[0] : (const float*)args.out) + r0 * D, args.out + r0 * D, XB + r0 * D, l + 1 < DEPTH ? RS + (size_t)(2 * l + 2) * M + r0 : nullptr, D, nullptr, nullptr, DEFER_RES ? YB + r0 * D : (const bf16*)nullptr};
                  pg8::gemm_phase<pg8::EpiRes<false, NEED_XB, DEFER_RES>, pg8::FfnOrder, GP_ALIGN, GP_SP2>(F.lds + RING_OFF, g, S, E); }
            }
            { constexpr int hf = 1;
                const size_t r0 = 0;
                int pmf = 0;
#if I8_FF1
                { pg8::Gemm g{(const bf16*)(ws + WS_XB8 + r0 * D), (const bf16*)(ws + WS_W18 + (size_t)l * DFF * D), M, DFF, D / 2, KROT(D / 2)}; pg8::FfnOrder S; S.init(M / 2, DFF, F.G, (int)blockIdx.x, hf);
                  pg8::Unit u0_; const int pmt = S.next(0, u0_) ? u0_.pm : -1; pmf = pmt;
                  __syncthreads();
                  build_sw_tab(F, S, (const float*)(ws + WS_SW1) + l * DFF, 0);
#if QUANT_BOTH
                  tab_from_sx(F, (const float*)(ws + WS_SX) + r0 + pmt * 256);
#else
                  quant_coop(F, S, pmt, XB + (r0 + (size_t)pmt * 256) * D, NEED_XB ? (const float*)nullptr : (DEFER_RES && l == 0 ? args.in[0] : (const float*)args.out) + (r0 + (size_t)pmt * 256) * D, DEFER_RES ? YB + (r0 + (size_t)pmt * 256) * D : (const bf16*)nullptr, (signed char*)(ws + WS_XB8) + (r0 + (size_t)pmt * 256) * D, (float*)(ws + WS_SX) + r0 + pmt * 256, RS + (size_t)(2 * l + 1) * M + r0 + pmt * 256,
                             PCNT(1 + hf, pmt), bar.bar);
#endif
                  pg8::EpiFF1<true, pg8::NoSide, true> E8{HID + r0 * DFF, RS + (size_t)(2 * l + 1) * M + r0, DFF, (const LAS float*)(F.lds + RS_TAB_OFF), pmt, pg8::NoSide{}, (const LAS float*)(F.lds + SW_TAB_OFF)};
                  pg8::gemm_phase<pg8::EpiFF1<true, pg8::NoSide, true>, pg8::FfnOrder, GP_ALIGN, GP_SP2, 1>(F.lds + RING_OFF, g, S, E8); }
#else
                { pg8::Gemm g{XB + r0 * D, W1, M / 2, DFF, D, KROT(D)}; pg8::StaticOrder S; S.init(M / 2, DFF, F.G, (int)blockIdx.x);
                  const int pmt = build_rs_tab(F, S, RS + (size_t)(2 * l + 1) * M + r0);
                  typedef typename SideSel<(CONV_L >= 0) && !CONV_IN_MIX, (CONV_L >= 0 ? CONV_L : 0), 9 + 4 * hf>::T SideT; const SideT side{};
                  pg8::EpiFF1<true, SideT> E{HID + r0 * DFF, RS + (size_t)(2 * l + 1) * M + r0, DFF, (const LAS float*)(F.lds + RS_TAB_OFF), pmt, side, nullptr}; pg8::EpiFF1<false, SideT> EG{HID + r0 * DFF, RS + (size_t)(2 * l + 1) * M + r0, DFF, nullptr, pmt, side, nullptr};
                  if (pmt >= 0) pg8::gemm_phase<pg8::EpiFF1<true, SideT>, pg8::StaticOrder, GP_ALIGN, GP_SP2>(F.lds + RING_OFF, g, S, E);
                  else if (pmt == -2) pg8::gemm_phase<pg8::EpiFF1<false, SideT>, pg8::StaticOrder, GP_ALIGN, GP_SP2>(F.lds + RING_OFF, g, S, EG); }
#endif
                if (DATAFLOW && I8_FF1 && F.G == 256) panel_barrier(PCNT(4 + hf, pmf), (unsigned)(F.G / (M / 2 / 256)), bar.bar); else xcd_barrier(bar);
                { pg8::Gemm g{HID + r0 * DFF, W2, M, D, DFF, KROT(DFF)}; pg8::FfnOrder S; S.init(M / 2, D, F.G, (int)blockIdx.x, hf);
                  pg8::EpiRes<false, NEED_XB, DEFER_RES> E{(DEFER_RES && l == 0 ? args.in[0] : (const float*)args.out) + r0 * D, args.out + r0 * D, XB + r0 * D, l + 1 < DEPTH ? RS + (size_t)(2 * l + 2) * M + r0 : nullptr, D, nullptr, nullptr, DEFER_RES ? YB + r0 * D : (const bf16*)nullptr};
                  pg8::gemm_phase<pg8::EpiRes<false, NEED_XB, DEFER_RES>, pg8::FfnOrder, GP_ALIGN, GP_SP2>(F.lds + RING_OFF, g, S, E); }
            }
            SEAM(p + 5);
        }
#else
        if (IN(p + 4)) {
            phase_stagger();
            pg8::Gemm g{XB, W1, M, DFF, D, KROT(D)}; pg8::StaticOrder S; S.init(M, DFF, F.G, (int)blockIdx.x);
            const int pmt = build_rs_tab(F, S, RS + (size_t)(2 * l + 1) * M);
            pg8::EpiFF1<true> E{HID, RS + (size_t)(2 * l + 1) * M, DFF, (const LAS float*)(F.lds + RS_TAB_OFF), pmt, pg8::NoSide{}, nullptr}; pg8::EpiFF1<false> EG{HID, RS + (size_t)(2 * l + 1) * M, DFF, nullptr, pmt, pg8::NoSide{}, nullptr};
            if (pmt >= 0) pg8::gemm_phase<pg8::EpiFF1<true>, pg8::StaticOrder, GP_ALIGN, GP_SP2>(F.lds + RING_OFF, g, S, E);
            else if (pmt == -2) pg8::gemm_phase<pg8::EpiFF1<false>, pg8::StaticOrder, GP_ALIGN, GP_SP2>(F.lds + RING_OFF, g, S, EG);
            SEAM(p + 4);
        }
        if (IN(p + 5)) {
            phase_stagger();
            pg8::Gemm g{HID, W2, M, D, DFF, KROT(DFF)}; pg8::StaticOrder S; S.init(M, D, F.G, (int)blockIdx.x);
            pg8::EpiRes<false> E{(const float*)args.out, args.out, XB, l + 1 < DEPTH ? RS + (size_t)(2 * l + 2) * M : nullptr, D, nullptr, nullptr};
            if (PROBE_DUP == 6) { pg8::EpiNull EN{args.out}; pg8::gemm_phase<pg8::EpiNull, pg8::StaticOrder, GP_ALIGN, GP_SP2>(F.lds + RING_OFF, g, S, EN); }
            pg8::gemm_phase<pg8::EpiRes<false>, pg8::StaticOrder, GP_ALIGN, GP_SP2>(F.lds + RING_OFF, g, S, E);
            SEAM(p + 5);
        }
#endif
    }
__global__ void __launch_bounds__(NWAVES * 64, 2) mk_fwd(Args args) {
    extern __shared__ __attribute__((aligned(16))) unsigned char lds[];
    Frame F;
    F.lds = (LAS unsigned char*)lds;
    F.MISC = (volatile LAS unsigned*)(F.lds + MISC_OFF);
    F.tid = threadIdx.x; F.lane = F.tid & 63; F.wave = __builtin_amdgcn_readfirstlane(F.tid >> 6);
    F.G = gridDim.x; { const int bx = blockIdx.x; F.vcu = (F.G % 8 == 0) ? (bx % 8) * (F.G / 8) + bx / 8 : bx; }
    unsigned char* ws = args.ws;
    F.ctl = (gu32*)(ws + WS_CTL);
    for (int u = F.tid; u < (LDS_BYTES - LDSCTL_OFF) / 4; u += NWAVES * 64) ((LAS unsigned*)(F.lds + LDSCTL_OFF))[u] = 0u;
    __syncthreads();
    XcdBarrier bar; bar.bar = (unsigned*)(F.ctl + CW_BAR); bar.x = 0; bar.st = nullptr;
    if (!MK_PER_PHASE) bar = xcd_barrier_post((unsigned*)(F.ctl + CW_BAR), F.MISC + 8);
    const int lo = args.ph_lo, hi = args.ph_hi;

    if (IN(0)) { p0_prologue(F, args, ws); if (PROBE_DUP == 0) { __syncthreads(); p0_prologue(F, args, ws); } SEAM(0); }

    run_layer<0>(F, args, ws, bar, lo, hi); run_layer<1>(F, args, ws, bar, lo, hi); run_layer<2>(F, args, ws, bar, lo, hi); run_layer<3>(F, args, ws, bar, lo, hi);
#undef IN
#undef SEAM
}

extern "C" void kernel_launch(void* const* d_in, const int* in_sizes, int n_in, void* d_out, int out_size, void* d_ws, size_t ws_size, hipStream_t stream) {
    static int grid = 0;
    if (grid == 0) {
        if (n_in != 15 || in_sizes[0] != M * D || out_size != M * D || ws_size < WS_END) { fprintf(stderr, "kernel_launch: shape/workspace mismatch: n_in %d in0 %d out %d ws %zu (need %zu); nothing launched\n", n_in, n_in > 0 ? in_sizes[0] : -1, out_size, ws_size, (size_t)WS_END); grid = -1; return; }
        int dev = 0, cus = 0, per_cu = 0;
        if (hipGetDevice(&dev) != hipSuccess || hipDeviceGetAttribute(&cus, hipDeviceAttributeMultiprocessorCount, dev) != hipSuccess) { fprintf(stderr, "kernel_launch: device query failed\n"); grid = -1; return; }
        if (hipFuncSetAttribute((const void*)mk_fwd, hipFuncAttributeMaxDynamicSharedMemorySize, LDS_BYTES) != hipSuccess) { fprintf(stderr, "kernel_launch: hipFuncSetAttribute failed\n"); grid = -1; return; }
        if (hipOccupancyMaxActiveBlocksPerMultiprocessor(&per_cu, (const void*)mk_fwd, NWAVES * 64, LDS_BYTES) != hipSuccess || per_cu < 1)
            fprintf(stderr, "kernel_launch: note: occupancy query reports %d workgroups per CU\n", per_cu);
        (void)hipGetLastError();
        grid = cus;
    }
    if (grid < 0) return;
    if (hipMemsetAsync((char*)d_ws + WS_CTL, 0, CTL_ZERO_BYTES, stream) != hipSuccess) { fprintf(stderr, "kernel_launch: memset failed\n"); return; }
    Args a{};
    for (int i = 0; i < 15; ++i) a.in[i] = (const float*)d_in[i];
    a.out = (float*)d_out; a.ws = (unsigned char*)d_ws;
#if MK_PER_PHASE
    for (int ph = 0; ph < N_PHASES; ++ph) { a.ph_lo = ph; a.ph_hi = ph + 1; hipLaunchKernelGGL(mk_fwd, dim3(grid), dim3(NWAVES * 64), LDS_BYTES, stream, a); }
#else
    a.ph_lo = 0; a.ph_hi = N_PHASES;
    hipLaunchKernelGGL(mk_fwd, dim3(grid), dim3(NWAVES * 64), LDS_BYTES, stream, a);
#endif
    const hipError_t le = hipPeekAtLastError();
    if (le != hipSuccess) fprintf(stderr, "kernel_launch: launch failed: %s\n", hipGetErrorName(le));
}
```

```cpp
#include <hip/hip_runtime.h>
#include <cstdio>
#include <cstdint>
#ifndef EPI_DRAIN
#define EPI_DRAIN 0
#endif
#ifndef GP_SP2
#define GP_SP2 true
#endif
#ifndef GP_ALIGN
#define GP_ALIGN true
#endif
#ifndef GEMM_ROT
#define GEMM_ROT 4
#endif
#ifndef FFN_SPLIT
#define FFN_SPLIT 1
#endif
#ifndef EPI_NT
#define EPI_NT 0
#endif
#ifndef I8_INPROJ
#define I8_INPROJ 1
#endif
#ifndef I8_FF1
#define I8_FF1 1
#endif
static_assert(!I8_FF1 || I8_INPROJ, "I8_FF1 needs I8_INPROJ");
#ifndef MIX_LOCAL
#define MIX_LOCAL 1
#endif
#ifndef GATES8
#define GATES8 1
#endif
#ifndef I8_OUT
#define I8_OUT 1
#endif
static_assert(!I8_OUT || I8_INPROJ, "I8_OUT needs I8_INPROJ");
static_assert(!GATES8 || (I8_INPROJ && I8_FF1), "GATES8 lives in the bf16 FFN-up copy's region and is written by the int8 in-projection epilogue only");
namespace pg8 {
#define PG8_LAS __attribute__((address_space(3)))
typedef unsigned short bf16_t;
typedef short bf16x8 __attribute__((ext_vector_type(8)));
typedef float f32x4 __attribute__((ext_vector_type(4)));
typedef unsigned u32x4 __attribute__((ext_vector_type(4)));
typedef int i32x4_t __attribute__((ext_vector_type(4)));
constexpr int BM = 256, BK = 64, HALF = 128, HTB = HALF * BK * 2  , STAGE_BYTES = 8 * HTB, NXCD = 8, WGM = 8;

__host__ __device__ __forceinline__ int lds_byte(int r, int c) { const int st = (r >> 4) * 2 + (c >> 5), rr = r & 15, cc = c & 31, ob = rr * 64 + cc * 2; return st * 1024 + (ob ^ (((ob >> 9) & 1) << 5)); }
__host__ __device__ __forceinline__ void stage_rc(int b, int& R, int& C) { const int st = b / 1024, sb = b % 1024, swz = sb ^ (((sb >> 9) & 1) << 5); R = (st >> 1) * 16 + swz / 64; C = (st & 1) * 32 + (swz % 64) / 2; }
__host__ __device__ __forceinline__ int perm32(int rho) { const int n = rho >> 4, i = rho & 15; return 8 * (i >> 2) + 4 * n + (i & 3); }

struct Unit { int pm, pn, ord; };
struct Gemm { const bf16_t* A; const bf16_t* Bt; int M, N, K, krot; };

struct StaticOrder {
    int nM, nN, nwg, G, c, rot;
    __host__ __device__ void init(int M, int N, int G_, int c_) { nM = M / BM; nN = N / BM; nwg = nM * nN; G = G_; c = c_; rot = (GEMM_ROT && nwg % NXCD == 0 && (nwg / NXCD) % (WGM * nN) == 0 && nM % WGM == 0 && G_ % NXCD == 0) ? (GEMM_ROT * (c_ % NXCD)) % nN : 0; }
    __host__ __device__ bool next(int i, Unit& u) const {
        const long L = (long)i * G + c; if (L >= nwg) return false;
        int wgid = (int)L; { const int q = nwg / NXCD, r = nwg % NXCD, xcd = wgid % NXCD, off = wgid / NXCD; wgid = (xcd < r ? xcd * (q + 1) : r * (q + 1) + (xcd - r) * q) + off; }
        const int nig = WGM * nN, gid = wgid / nig, fm = gid * WGM, gsz = (nM - fm) < WGM ? (nM - fm) : WGM;
        u.pm = fm + ((wgid % nig) % gsz); u.pn = (wgid % nig) / gsz + rot; if (u.pn >= nN) u.pn -= nN; return true;
    }
    __device__ __forceinline__ void a_ready(const Unit&) const {}
    __device__ __forceinline__ void done(const Unit&) const {}
};

__device__ __forceinline__ unsigned cvt_pk_bf16(float lo, float hi) { typedef __bf16 bf2_t __attribute__((ext_vector_type(2))); typedef float f2_t __attribute__((ext_vector_type(2))); const f2_t v = {lo, hi}; return __builtin_bit_cast(unsigned, __builtin_convertvector(v, bf2_t)); }
typedef float f32x2 __attribute__((ext_vector_type(2)));
__device__ __forceinline__ f32x2 gelu_pk(f32x2 v) {
    const f32x2 av = __builtin_elementwise_abs(v), d = av * 0.2316418882f + 1.0f;
    f32x2 t; t.x = __builtin_amdgcn_rcpf(d.x); t.y = __builtin_amdgcn_rcpf(d.y);
    f32x2 q = t * 0.5307027145f + (-0.7265760135f); q = q * t + 0.7107068705f; q = q * t + (-0.142248368f); q = q * t + 0.127414796f; q = q * t;
    const f32x2 s = (v * v) * (-0.72134752044f);
    f32x2 e; e.x = __builtin_amdgcn_exp2f(s.x); e.y = __builtin_amdgcn_exp2f(s.y);
    const f32x2 m = v * (q * e), r = v - m;
    f32x2 o; o.x = v.x < 0.f ? m.x : r.x; o.y = v.y < 0.f ? m.y : r.y; return o;
}

__device__ __forceinline__ float bf_lo(unsigned w) { return __uint_as_float(w << 16); }
__device__ __forceinline__ float bf_hi(unsigned w) { return __uint_as_float(w & 0xffff0000u); }
__device__ __forceinline__ float sigmoid_f(float v) { return __builtin_amdgcn_rcpf(1.0f + __builtin_amdgcn_exp2f(v * -1.4426950409f)); }

struct RsPre { unsigned long long q[2][4]; };
__device__ __forceinline__ void rs_prefetch(const unsigned long long* rowsq, int row0, RsPre& p) {
#pragma unroll
    for (int ai = 0; ai < 2; ++ai)
#pragma unroll
        for (int m = 0; m < 4; ++m) p.q[ai][m] = rowsq[row0 + ai * HALF + m * 16];
}
__device__ __forceinline__ void rs_from(const RsPre& p, float (&rs)[2][4]) {
#pragma unroll
    for (int ai = 0; ai < 2; ++ai)
#pragma unroll
        for (int m = 0; m < 4; ++m) rs[ai][m] = __builtin_amdgcn_rsqf((float)p.q[ai][m] * (1.0f / (2048.0f * 16777216.0f)) + 1e-6f);
}
struct NoPre {};
__device__ __forceinline__ float rs_of(unsigned long long q) { return __builtin_amdgcn_rsqf((float)q * (1.0f / (2048.0f * 16777216.0f)) + 1e-6f); }
template <bool TAB> __device__ __forceinline__ void rs_get(const unsigned long long* rowsq, const PG8_LAS float* tab, int pm, int r0, float (&rs)[2][4]) {
    if constexpr (TAB) {
#pragma unroll
        for (int ai = 0; ai < 2; ++ai)
#pragma unroll
            for (int m = 0; m < 4; ++m) rs[ai][m] = tab[r0 + ai * HALF + m * 16]; }
    else { RsPre p; rs_prefetch(rowsq, pm * BM + r0, p); rs_from(p, rs); }
}
#if EPI_NT
#define EPI_STORE16(p, v) __builtin_nontemporal_store((v), (u32x4*)(p))
#else
#define EPI_STORE16(p, v) (*(u32x4*)(p) = (v))
#endif
template <int KIND, bool I8 = false> __device__ __forceinline__ void act_store_bf16(const f32x4 (&acc)[2][2][4][2], const float (&rs)[2][4], bf16_t* base  , int ldc, const PG8_LAS float* swp = nullptr) {
    f32x4 sw0[2], sw1[2];
    if constexpr (I8) {
#pragma unroll
        for (int bj = 0; bj < 2; ++bj) { sw0[bj] = *(const PG8_LAS f32x4*)(swp + bj * HALF); sw1[bj] = *(const PG8_LAS f32x4*)(swp + bj * HALF + 4); } }
#pragma unroll
    for (int ai = 0; ai < 2; ++ai)
#pragma unroll
        for (int m = 0; m < 4; ++m) { bf16_t* rowp = base + (size_t)(ai * HALF + m * 16) * ldc; const float r = rs[ai][m];
#pragma unroll
            for (int bj = 0; bj < 2; ++bj) { f32x4 v0, v1;
                if constexpr (I8) { const i32x4_t a0 = __builtin_bit_cast(i32x4_t, acc[ai][bj][m][0]), a1 = __builtin_bit_cast(i32x4_t, acc[ai][bj][m][1]);
                    v0 = (f32x4){(float)a0[0], (float)a0[1], (float)a0[2], (float)a0[3]} * sw0[bj] * r; v1 = (f32x4){(float)a1[0], (float)a1[1], (float)a1[2], (float)a1[3]} * sw1[bj] * r; }
                else { v0 = acc[ai][bj][m][0] * r; v1 = acc[ai][bj][m][1] * r; }
                if (KIND == 1) { f32x2 a = gelu_pk((f32x2){v0[0], v0[1]}), b = gelu_pk((f32x2){v0[2], v0[3]}), c = gelu_pk((f32x2){v1[0], v1[1]}), d = gelu_pk((f32x2){v1[2], v1[3]});
                    v0 = (f32x4){a.x, a.y, b.x, b.y}; v1 = (f32x4){c.x, c.y, d.x, d.y}; }
                if (KIND == 2) {
#pragma unroll
                    for (int j = 0; j < 4; ++j) { v0[j] = sigmoid_f(v0[j]); v1[j] = sigmoid_f(v1[j]); } }
                if (KIND == 3) {
#pragma unroll
                    for (int j = 0; j < 4; ++j) { const float a = fmaxf(v0[j], 0.f), b = fmaxf(v1[j], 0.f); v0[j] = a * a; v1[j] = b * b; } }
                u32x4 w; w.x = cvt_pk_bf16(v0[0], v0[1]); w.y = cvt_pk_bf16(v0[2], v0[3]); w.z = cvt_pk_bf16(v1[0], v1[1]); w.w = cvt_pk_bf16(v1[2], v1[3]);
                EPI_STORE16(rowp + bj * HALF, w); } }
}
template <bool I8> __device__ __forceinline__ void gate_store_u8(const f32x4 (&acc)[2][2][4][2], const float (&rs)[2][4], unsigned char* dst  , const PG8_LAS float* swp) {
    f32x4 sw0[2], sw1[2];
    if constexpr (I8) {
#pragma unroll
        for (int bj = 0; bj < 2; ++bj) { sw0[bj] = *(const PG8_LAS f32x4*)(swp + bj * HALF); sw1[bj] = *(const PG8_LAS f32x4*)(swp + bj * HALF + 4); } }
#pragma unroll
    for (int ai = 0; ai < 2; ++ai)
#pragma unroll
        for (int bj = 0; bj < 2; ++bj)
#pragma unroll
            for (int mh = 0; mh < 2; ++mh) { u32x4 w;
#pragma unroll
                for (int mm = 0; mm < 2; ++mm) { const int m = 2 * mh + mm; const float r = rs[ai][m]; f32x4 v0, v1;
                    if constexpr (I8) { const i32x4_t a0 = __builtin_bit_cast(i32x4_t, acc[ai][bj][m][0]), a1 = __builtin_bit_cast(i32x4_t, acc[ai][bj][m][1]);
                        v0 = (f32x4){(float)a0[0], (float)a0[1], (float)a0[2], (float)a0[3]} * sw0[bj] * r; v1 = (f32x4){(float)a1[0], (float)a1[1], (float)a1[2], (float)a1[3]} * sw1[bj] * r; }
                    else { v0 = acc[ai][bj][m][0] * r; v1 = acc[ai][bj][m][1] * r; }
                    unsigned q[8];
#pragma unroll
                    for (int j = 0; j < 4; ++j) { q[j] = (unsigned)__builtin_rintf(sigmoid_f(v0[j]) * 255.0f); q[4 + j] = (unsigned)__builtin_rintf(sigmoid_f(v1[j]) * 255.0f); }
                    const unsigned lo = q[0] | (q[1] << 8) | (q[2] << 16) | (q[3] << 24), hi = q[4] | (q[5] << 8) | (q[6] << 16) | (q[7] << 24);
                    if (mm == 0) { w.x = lo; w.y = hi; } else { w.z = lo; w.w = hi; } }
                EPI_STORE16(dst + (ai * 4 + bj * 2 + mh) * 1024, w); }
}
struct NoSide { struct State {}; __device__ __forceinline__ void begin(int, int, State&) const {} __device__ __forceinline__ void end(int, State&) const {} };
template <bool TAB, class Side = NoSide, bool I8 = false> struct EpiIn {
    static constexpr bool PERM = true, AFTER_DRAIN = false, CHAIN = false;
    bf16_t* O; const unsigned long long* rowsq; int ldc; const PG8_LAS float* rs_tab; int pm_tab; Side side; int pn_off; const PG8_LAS float* sw; unsigned char* g8;
    typedef NoPre Pre;
    __device__ __forceinline__ void prefetch(const Unit&, int, int, int, int, Pre&) const {}
    __device__ __forceinline__ void operator()(const f32x4 (&acc)[2][2][4][2], const Unit& u, int wr, int wc, int fr, int fq, const Pre&) const {
        const int pn = u.pn + pn_off; const int row0 = u.pm * BM + wr * 64 + fr, col0 = pn * BM + wc * 32 + 8 * fq;
        typename Side::State sst; side.begin(u.ord, fr + 16 * fq, sst);
        float rs[2][4]; rs_get<TAB>(rowsq, rs_tab, u.pm, wr * 64 + fr, rs);
        bf16_t* base = O + (size_t)row0 * ldc + col0;
        const PG8_LAS float* swp = I8 ? sw + u.ord * 256 + wc * 32 + 8 * fq : nullptr;
        if (pn < 12) act_store_bf16<0, I8>(acc, rs, base, ldc, swp); else if (pn < 20) act_store_bf16<1, I8>(acc, rs, base, ldc, swp);
#if GATES8
        else gate_store_u8<I8>(acc, rs, g8 + ((size_t)((pn >= 28 ? 512 : 0) + u.pm * 8 + (pn >= 28 ? pn - 28 : pn - 20)) << 16) + (wr * 4 + wc) * 8192 + (fr + 16 * fq) * 16, swp);
#else
        else act_store_bf16<2, I8>(acc, rs, base, ldc, swp);
#endif
        side.end(fr + 16 * fq, sst);
    }
};
template <bool TAB, class Side = NoSide, bool I8 = false> struct EpiFF1 {
    static constexpr bool PERM = true, AFTER_DRAIN = false, CHAIN = false;
    bf16_t* O; const unsigned long long* rowsq; int ldc; const PG8_LAS float* rs_tab; int pm_tab; Side side; const PG8_LAS float* sw;
    typedef NoPre Pre;
    __device__ __forceinline__ void prefetch(const Unit&, int, int, int, int, Pre&) const {}
    __device__ __forceinline__ void operator()(const f32x4 (&acc)[2][2][4][2], const Unit& u, int wr, int wc, int fr, int fq, const Pre&) const {
        const int row0 = u.pm * BM + wr * 64 + fr, col0 = u.pn * BM + wc * 32 + 8 * fq;
        typename Side::State sst; side.begin(u.ord, fr + 16 * fq, sst);
        float rs[2][4]; rs_get<TAB>(rowsq, rs_tab, u.pm, wr * 64 + fr, rs);
        act_store_bf16<3, I8>(acc, rs, O + (size_t)row0 * ldc + col0, ldc, I8 ? sw + u.ord * 256 + wc * 32 + 8 * fq : nullptr);
        side.end(fr + 16 * fq, sst);
    }
};
template <bool I8 = false, bool WXB = true, bool ADDY = false> struct EpiRes {
    static constexpr bool PERM = false, AFTER_DRAIN = false, CHAIN = false;
    const float* xin; float* xout; bf16_t* xb; unsigned long long* rowsq_out; int ldc; const PG8_LAS float* tab; const float* sw; const bf16_t* y;
    typedef NoPre Pre;
    __device__ __forceinline__ void prefetch(const Unit&, int, int, int, int, Pre&) const {}
    __device__ __forceinline__ void operator()(const f32x4 (&acc)[2][2][4][2], const Unit& u, int wr, int wc, int fr, int fq, const Pre&) const {
        typedef unsigned u32x2v __attribute__((ext_vector_type(2)));
        const int row0 = u.pm * BM + wr * 64 + fr, col0 = u.pn * BM + wc * 32 + 4 * fq;
        f32x4 swv[2][2];
        if constexpr (I8) {
#pragma unroll
            for (int bj = 0; bj < 2; ++bj)
#pragma unroll
                for (int n = 0; n < 2; ++n) swv[bj][n] = *(const f32x4*)(sw + col0 + bj * HALF + n * 16); }
        constexpr int MB = ADDY ? 2 : 4;
#pragma unroll
        for (int ab = 0; ab < 2 * (4 / MB); ++ab) { const int ai = ab / (4 / MB), m0 = (ab % (4 / MB)) * MB;
            f32x4 xo[4][2][2]; u32x2v yo[4][2][2];
#pragma unroll
            for (int m = m0; m < m0 + MB; ++m)
#pragma unroll
                for (int bj = 0; bj < 2; ++bj)
#pragma unroll
                    for (int n = 0; n < 2; ++n) { xo[m][bj][n] = *(const f32x4*)(xin + (size_t)(row0 + ai * HALF + m * 16) * ldc + col0 + bj * HALF + n * 16);
                        if constexpr (ADDY) yo[m][bj][n] = *(const u32x2v*)(y + (size_t)(row0 + ai * HALF + m * 16) * ldc + col0 + bj * HALF + n * 16); }
#pragma unroll
            for (int m = m0; m < m0 + MB; ++m) { const int row = row0 + ai * HALF + m * 16; const size_t off = (size_t)row * ldc + col0; float ss = 0.f;
#pragma unroll
                for (int bj = 0; bj < 2; ++bj)
#pragma unroll
                    for (int n = 0; n < 2; ++n) { f32x4 av = acc[ai][bj][m][n];
                        if constexpr (I8) { const i32x4_t a = __builtin_bit_cast(i32x4_t, av); av = (f32x4){(float)a[0], (float)a[1], (float)a[2], (float)a[3]} * swv[bj][n] * tab[wr * 64 + fr + ai * HALF + m * 16]; }
                        f32x4 xr = xo[m][bj][n];
                        if constexpr (ADDY) { const u32x2v yw = yo[m][bj][n]; xr = xr + (f32x4){bf_lo(yw.x), bf_hi(yw.x), bf_lo(yw.y), bf_hi(yw.y)}; }
                        const f32x4 xn = xr + av;
                        *(f32x4*)(xout + off + bj * HALF + n * 16) = xn;
                        if constexpr (WXB) { u32x2v w; w.x = cvt_pk_bf16(xn[0], xn[1]); w.y = cvt_pk_bf16(xn[2], xn[3]); *(u32x2v*)(xb + off + bj * HALF + n * 16) = w;
                            ss += (xn[0] * xn[0] + xn[1] * xn[1]) + (xn[2] * xn[2] + xn[3] * xn[3]); } }
                if constexpr (WXB) { ss += __shfl_xor(ss, 16); ss += __shfl_xor(ss, 32);
                    if (rowsq_out != nullptr && fq == 0) __hip_atomic_fetch_add(rowsq_out + row, (unsigned long long)(ss * 16777216.0f + 0.5f), __ATOMIC_RELAXED, __HIP_MEMORY_SCOPE_AGENT); } }
            asm volatile("" ::: "memory"); }
    }
};
struct EpiBf {
    static constexpr bool PERM = true, AFTER_DRAIN = false, CHAIN = false;
    bf16_t* O; int ldc;
    typedef NoPre Pre;
    __device__ __forceinline__ void prefetch(const Unit&, int, int, int, int, Pre&) const {}
    __device__ __forceinline__ void operator()(const f32x4 (&acc)[2][2][4][2], const Unit& u, int wr, int wc, int fr, int fq, const Pre&) const {
        const int row0 = u.pm * BM + wr * 64 + fr, col0 = u.pn * BM + wc * 32 + 8 * fq;
        const float rs[2][4] = {{1.f, 1.f, 1.f, 1.f}, {1.f, 1.f, 1.f, 1.f}};
        act_store_bf16<0, false>(acc, rs, O + (size_t)row0 * ldc + col0, ldc);
    }
};
struct EpiBf8 {
    static constexpr bool PERM = true, AFTER_DRAIN = false, CHAIN = false;
    bf16_t* O; int ldc; const PG8_LAS float* tab; const PG8_LAS float* sw;
    typedef NoPre Pre;
    __device__ __forceinline__ void prefetch(const Unit&, int, int, int, int, Pre&) const {}
    __device__ __forceinline__ void operator()(const f32x4 (&acc)[2][2][4][2], const Unit& u, int wr, int wc, int fr, int fq, const Pre&) const {
        const int row0 = u.pm * BM + wr * 64 + fr, col0 = u.pn * BM + wc * 32 + 8 * fq;
        float rs[2][4];
#pragma unroll
        for (int ai = 0; ai < 2; ++ai)
#pragma unroll
            for (int m = 0; m < 4; ++m) rs[ai][m] = tab[wr * 64 + fr + ai * HALF + m * 16];
        act_store_bf16<0, true>(acc, rs, O + (size_t)row0 * ldc + col0, ldc, sw + u.ord * 256 + wc * 32 + 8 * fq);
    }
};
struct EpiYab {
    static constexpr bool PERM = true, AFTER_DRAIN = false, CHAIN = true;
    const bf16_t* proj; bf16_t* MG; int ldp, ga_col, gb_col, ldc, nM1, nN1; const unsigned char* g8;
    typedef NoPre Pre;
    __device__ __forceinline__ void prefetch(const Unit&, int, int, int, int, Pre&) const {}
    __device__ __forceinline__ bool chain(f32x4 (&acc)[2][2][4][2], const Unit& u, int wr, int wc, int fr, int fq) const {
        const bool second = u.pm >= nM1; const int pm = second ? u.pm - nM1 : u.pm, pn = second ? u.pn - nN1 : u.pn;
        const int row0 = pm * BM + wr * 64 + fr, col0 = pn * BM + wc * 32 + 8 * fq; constexpr float TINY = 8.673617379884035e-19f;
#if GATES8
        const unsigned char* gt = g8 + ((size_t)(pm * 8 + pn) << 16) + (wr * 4 + wc) * 8192 + (fr + 16 * fq) * 16;
#define UB4(w) ((f32x4){(float)((w) & 255u), (float)(((w) >> 8) & 255u), (float)(((w) >> 16) & 255u), (float)((w) >> 24)} * (1.0f / 255.0f))
#endif
#if GATES8
        u32x4 gbq8[8], gaq8[8];
#pragma unroll
        for (int k = 0; k < 8; ++k) { gbq8[k] = *(const u32x4*)(gt + ((size_t)512 << 16) + k * 1024); if (!second) gaq8[k] = *(const u32x4*)(gt + k * 1024); }
#endif
#pragma unroll
        for (int ai = 0; ai < 2; ++ai) {
#if GATES8
            u32x4 gbq[4], gaq[4];
#pragma unroll
            for (int k = 0; k < 4; ++k) { gbq[k] = gbq8[ai * 4 + k]; if (!second) gaq[k] = gaq8[ai * 4 + k]; }
#else
            u32x4 gb[4][2], ga[4][2];
#pragma unroll
            for (int m = 0; m < 4; ++m)
#pragma unroll
                for (int bj = 0; bj < 2; ++bj) { const bf16_t* gp = proj + (size_t)(row0 + ai * HALF + m * 16) * ldp + col0 + bj * HALF; gb[m][bj] = *(const u32x4*)(gp + gb_col); if (!second) ga[m][bj] = *(const u32x4*)(gp + ga_col); }
#endif
#pragma unroll
            for (int m = 0; m < 4; ++m)
#pragma unroll
                for (int bj = 0; bj < 2; ++bj) {
#if GATES8
                    const unsigned glo = (m & 1) ? gbq[bj * 2 + (m >> 1)].z : gbq[bj * 2 + (m >> 1)].x, ghi = (m & 1) ? gbq[bj * 2 + (m >> 1)].w : gbq[bj * 2 + (m >> 1)].y;
                    const f32x4 g0 = UB4(glo), g1 = UB4(ghi);
                    const f32x4 b0 = (f32x4){fmaxf(g0[0], TINY), fmaxf(g0[1], TINY), fmaxf(g0[2], TINY), fmaxf(g0[3], TINY)}, b1 = (f32x4){fmaxf(g1[0], TINY), fmaxf(g1[1], TINY), fmaxf(g1[2], TINY), fmaxf(g1[3], TINY)};
                    if (!second) { const unsigned alo = (m & 1) ? gaq[bj * 2 + (m >> 1)].z : gaq[bj * 2 + (m >> 1)].x, ahi = (m & 1) ? gaq[bj * 2 + (m >> 1)].w : gaq[bj * 2 + (m >> 1)].y;
                        const f32x4 a0 = UB4(alo), a1 = UB4(ahi);
                        const f32x4 r0 = (f32x4){a0[0] * __builtin_amdgcn_rcpf(b0[0]), a0[1] * __builtin_amdgcn_rcpf(b0[1]), a0[2] * __builtin_amdgcn_rcpf(b0[2]), a0[3] * __builtin_amdgcn_rcpf(b0[3])};
                        const f32x4 r1 = (f32x4){a1[0] * __builtin_amdgcn_rcpf(b1[0]), a1[1] * __builtin_amdgcn_rcpf(b1[1]), a1[2] * __builtin_amdgcn_rcpf(b1[2]), a1[3] * __builtin_amdgcn_rcpf(b1[3])};
                        acc[ai][bj][m][0] *= r0; acc[ai][bj][m][1] *= r1; }
#else
                    const u32x4 g = gb[m][bj];
                    const f32x4 b0 = (f32x4){fmaxf(bf_lo(g.x), TINY), fmaxf(bf_hi(g.x), TINY), fmaxf(bf_lo(g.y), TINY), fmaxf(bf_hi(g.y), TINY)}, b1 = (f32x4){fmaxf(bf_lo(g.z), TINY), fmaxf(bf_hi(g.z), TINY), fmaxf(bf_lo(g.w), TINY), fmaxf(bf_hi(g.w), TINY)};
                    if (!second) { const u32x4 a = ga[m][bj];
                        const f32x4 r0 = (f32x4){bf_lo(a.x) * __builtin_amdgcn_rcpf(b0[0]), bf_hi(a.x) * __builtin_amdgcn_rcpf(b0[1]), bf_lo(a.y) * __builtin_amdgcn_rcpf(b0[2]), bf_hi(a.y) * __builtin_amdgcn_rcpf(b0[3])};
                        const f32x4 r1 = (f32x4){bf_lo(a.z) * __builtin_amdgcn_rcpf(b1[0]), bf_hi(a.z) * __builtin_amdgcn_rcpf(b1[1]), bf_lo(a.w) * __builtin_amdgcn_rcpf(b1[2]), bf_hi(a.w) * __builtin_amdgcn_rcpf(b1[3])};
                        acc[ai][bj][m][0] *= r0; acc[ai][bj][m][1] *= r1; }
#endif
                    else { const f32x4 v0 = acc[ai][bj][m][0] * b0, v1 = acc[ai][bj][m][1] * b1;
                        u32x4 w; w.x = cvt_pk_bf16(v0[0], v0[1]); w.y = cvt_pk_bf16(v0[2], v0[3]); w.z = cvt_pk_bf16(v1[0], v1[1]); w.w = cvt_pk_bf16(v1[2], v1[3]);
                        *(u32x4*)(MG + (size_t)(row0 + ai * HALF + m * 16) * ldc + col0 + bj * HALF) = w; } }
            asm volatile("" ::: "memory"); }
#if GATES8
#undef UB4
#endif
        return !second;
    }
};
struct EpiNull {
    static constexpr bool PERM = true, AFTER_DRAIN = false, CHAIN = false;
    float* sink;
    typedef NoPre Pre;
    __device__ __forceinline__ void prefetch(const Unit&, int, int, int, int, Pre&) const {}
    __device__ __forceinline__ void operator()(const f32x4 (&acc)[2][2][4][2], const Unit& u, int wr, int wc, int fr, int fq, const Pre&) const {
        if (u.pm < 0) { f32x4 t = (f32x4){0.f, 0.f, 0.f, 0.f};
#pragma unroll
            for (int ai = 0; ai < 2; ++ai)
#pragma unroll
                for (int bj = 0; bj < 2; ++bj)
#pragma unroll
                    for (int m = 0; m < 4; ++m)
#pragma unroll
                        for (int n = 0; n < 2; ++n) t += acc[ai][bj][m][n];
            *(f32x4*)(sink + (wr * 256 + wc * 64 + fq * 16 + fr) * 4) = t; }
    }
};
struct YabOrder {
    StaticOrder so; int nM1, nN1;
    __host__ __device__ void init(int M1, int N1, int G_, int c_) { so.init(M1, N1, G_, c_); nM1 = M1 / BM; nN1 = N1 / BM; }
    __host__ __device__ bool next(int i, Unit& u) const { if (!so.next(i >> 1, u)) return false; if (i & 1) { u.pm += nM1; u.pn += nN1; } return true; }
    __device__ __forceinline__ void a_ready(const Unit&) const {}
    __device__ __forceinline__ void done(const Unit&) const {}
};


struct SameOrder {
    int n, z;
    __host__ __device__ bool next(int i, Unit& u) const { if (i >= n) return false; u.pm = z; u.pn = z; return true; }
    __device__ __forceinline__ void a_ready(const Unit&) const {}
    __device__ __forceinline__ void done(const Unit&) const {}
};

struct SubOrder {
    StaticOrder so; int off, cnt;
    __host__ __device__ bool next(int i, Unit& u) const { if (i >= cnt) return false; return so.next(i + off, u); }
    __device__ __forceinline__ void a_ready(const Unit&) const {}
    __device__ __forceinline__ void done(const Unit&) const {}
};

struct InProjOrder {
    StaticOrder so; int x;
    __host__ __device__ void init(int M, int N, int G_, int c_) { so.init(M, N, G_, c_); so.rot = 0; x = c_ % NXCD; }
    __host__ __device__ bool next(int i, Unit& u) const {
        if (!so.next(i, u)) return false;
        if (so.nN != 36) return true;
        const int rnd = u.pn >> 2, j = u.pn & 3; const int nr = rnd < 4 ? 5 + ((rnd + x) & 3) : (rnd - 4 + x) % 5;
        u.pn = 4 * nr + j; return true;
    }
    __device__ __forceinline__ void a_ready(const Unit&) const {}
    __device__ __forceinline__ void done(const Unit&) const {}
};
template <class Epi, class Sched, bool ALIGN_EPI = false, bool SP2 = false, int MMA = 0  >
__device__ __forceinline__ void gemm_phase(PG8_LAS unsigned char* lds, const Gemm g, const Sched& S, const Epi& E) {
    const int tid = threadIdx.x, wid = __builtin_amdgcn_readfirstlane(tid >> 6), lane = tid & 63, wr = wid >> 2, wc = wid & 3, fr = lane & 15, fq = lane >> 4;
    const int K = g.K, nt = K / BK;
    unsigned voffA[2], voffB[2];
#pragma unroll
    for (int i = 0; i < 2; ++i) { int R, C; stage_rc(tid * 16 + i * 8192, R, C); const int Rb = Epi::PERM ? ((R & ~31) + perm32(R & 31)) : R;
        voffA[i] = (unsigned)(R * K + C) * 2u; voffB[i] = (unsigned)(Rb * K + C) * 2u; }
    const size_t kstep = (size_t)(BK * 2);
    const int kmask = nt - 1, t0 = ((nt & kmask) == 0) ? (g.krot & kmask) : 0;
#define PG8_KO(j) ((size_t)(((j) + t0) & kmask) * kstep)
    const size_t hstep = (size_t)HALF * K * 2;
    const size_t tstep = 2 * hstep;
    const unsigned ldsw = (unsigned)wid * 1024u;
    const int aoff = lds_byte(wr * 64 + fr, fq * 8), boff = lds_byte(wc * 32 + fr, fq * 8);
#define PG8_SA(b, h) (((b) * 2 + (h)) * HTB)
#define PG8_SB(b, h) ((4 + (b) * 2 + (h)) * HTB)
#define PG8_STAGE(bufoff, gbase, voff) do { _Pragma("unroll") for (int _i = 0; _i < 2; ++_i) \
        __builtin_amdgcn_global_load_lds((const unsigned*)((const char*)(gbase) + (voff)[_i]), (PG8_LAS unsigned*)(lds + (bufoff) + ldsw + _i * 8192), 16, 0, 0); } while (0)
#define PG8_LDA(dst, b, h) do { _Pragma("unroll") for (int m = 0; m < 4; ++m) _Pragma("unroll") for (int k = 0; k < 2; ++k) dst[m][k] = *(const PG8_LAS bf16x8*)(lds + PG8_SA(b, h) + aoff + m * 2048 + k * 1024); } while (0)
#define PG8_LDB(dst, b, h) do { _Pragma("unroll") for (int n = 0; n < 2; ++n) _Pragma("unroll") for (int k = 0; k < 2; ++k) dst[n][k] = *(const PG8_LAS bf16x8*)(lds + PG8_SB(b, h) + boff + n * 2048 + k * 1024); } while (0)
#define PG8_MMA(ai, bj, At, Bt) do { __builtin_amdgcn_s_setprio(1); _Pragma("unroll") for (int m = 0; m < 4; ++m) _Pragma("unroll") for (int n = 0; n < 2; ++n) _Pragma("unroll") for (int k = 0; k < 2; ++k) \
        { if constexpr (MMA == 1) acc[ai][bj][m][n] = __builtin_bit_cast(f32x4, __builtin_amdgcn_mfma_i32_16x16x64_i8(__builtin_bit_cast(i32x4_t, Bt[n][k]), __builtin_bit_cast(i32x4_t, At[m][k]), __builtin_bit_cast(i32x4_t, acc[ai][bj][m][n]), 0, 0, 0)); \
          else acc[ai][bj][m][n] = __builtin_amdgcn_mfma_f32_16x16x32_bf16(Bt[n][k], At[m][k], acc[ai][bj][m][n], 0, 0, 0); } __builtin_amdgcn_s_setprio(0); } while (0)
#define PG8_WAIT_V(n) asm volatile("s_waitcnt vmcnt(" #n ")" ::: "memory")
#define PG8_WAIT_L(n) asm volatile("s_waitcnt lgkmcnt(" #n ")" ::: "memory")
#define PG8_BAR __builtin_amdgcn_s_barrier()
#define PG8_SCHED __builtin_amdgcn_sched_barrier(0)
    Unit cur, nxt; int ui = 0;
    if (!S.next(0, cur)) return;
    f32x4 acc[2][2][4][2];
    typename Epi::Pre pre;
#pragma unroll
    for (int a = 0; a < 2; ++a)
#pragma unroll
        for (int b = 0; b < 2; ++b)
#pragma unroll
            for (int m = 0; m < 4; ++m)
#pragma unroll
                for (int n = 0; n < 2; ++n) acc[a][b][m][n] = (f32x4){0.f, 0.f, 0.f, 0.f};
    bf16x8 At[4][2], B0[2][2], B1[2][2];
    const char* cA = (const char*)g.A + (size_t)cur.pm * tstep; const char* cB = (const char*)g.Bt + (size_t)cur.pn * tstep;
    S.a_ready(cur);
    if constexpr (SP2) {
        PG8_STAGE(PG8_SB(0, 0), cB + PG8_KO(0), voffB); PG8_STAGE(PG8_SB(0, 1), cB + hstep + PG8_KO(0), voffB); PG8_STAGE(PG8_SA(0, 0), cA + PG8_KO(0), voffA); PG8_STAGE(PG8_SA(0, 1), cA + hstep + PG8_KO(0), voffA);
        if (wr == 1) PG8_BAR;
        PG8_WAIT_V(2); PG8_BAR;
        PG8_STAGE(PG8_SB(1, 0), cB + PG8_KO(1), voffB); PG8_STAGE(PG8_SA(1, 0), cA + PG8_KO(1), voffA); PG8_STAGE(PG8_SB(1, 1), cB + hstep + PG8_KO(1), voffB);
        PG8_WAIT_V(6); PG8_BAR;
    } else {
        PG8_STAGE(PG8_SB(0, 0), cB + PG8_KO(0), voffB); PG8_STAGE(PG8_SA(0, 0), cA + PG8_KO(0), voffA); PG8_STAGE(PG8_SB(0, 1), cB + hstep + PG8_KO(0), voffB); PG8_STAGE(PG8_SA(0, 1), cA + hstep + PG8_KO(0), voffA);
        if (wr == 1) PG8_BAR;
        PG8_WAIT_V(4); PG8_BAR;
        PG8_STAGE(PG8_SB(1, 0), cB + PG8_KO(1), voffB); PG8_STAGE(PG8_SA(1, 0), cA + PG8_KO(1), voffA); PG8_STAGE(PG8_SB(1, 1), cB + hstep + PG8_KO(1), voffB);
        PG8_WAIT_V(6); PG8_BAR;
    }
    for (;;) {
        const bool has_next = S.next(ui + 1, nxt);
        const char* nA = has_next ? (const char*)g.A + (size_t)nxt.pm * tstep : cA; const char* nB = has_next ? (const char*)g.Bt + (size_t)nxt.pn * tstep : cB;
        for (int t = 0; t < nt; t += 2) {
            const bool last = (t == nt - 2);
            const char* a1 = cA + PG8_KO(t + 1);
            const char* a2 = last ? nA + PG8_KO(0) : cA + PG8_KO(t + 2); const char* b2 = last ? nB + PG8_KO(0) : cB + PG8_KO(t + 2);
            const char* a3 = last ? nA + PG8_KO(1) : cA + PG8_KO(t + 3); const char* b3 = last ? nB + PG8_KO(1) : cB + PG8_KO(t + 3);
            if (last) E.prefetch(cur, wr, wc, fr, fq, pre);
            if (last && has_next) S.a_ready(nxt);
            if constexpr (SP2) {
            PG8_LDB(B0, 0, 0); PG8_LDB(B1, 0, 1); PG8_SCHED; PG8_LDA(At, 0, 0); PG8_STAGE(PG8_SA(1, 1), a1 + hstep, voffA);
            PG8_WAIT_V(8); PG8_WAIT_L(0); PG8_BAR; PG8_MMA(0, 0, At, B0); PG8_MMA(0, 1, At, B1); PG8_BAR; PG8_SCHED;
            PG8_LDA(At, 0, 1); PG8_STAGE(PG8_SB(0, 0), b2, voffB); PG8_STAGE(PG8_SB(0, 1), b2 + hstep, voffB); PG8_STAGE(PG8_SA(0, 0), a2, voffA);
            PG8_WAIT_V(8); PG8_WAIT_L(0); PG8_BAR; PG8_MMA(1, 0, At, B0); PG8_MMA(1, 1, At, B1); PG8_BAR; PG8_SCHED;
            PG8_LDB(B0, 1, 0); PG8_LDB(B1, 1, 1); PG8_SCHED; PG8_LDA(At, 1, 0); PG8_STAGE(PG8_SA(0, 1), a2 + hstep, voffA);
            PG8_WAIT_V(8); PG8_WAIT_L(0); PG8_BAR; PG8_MMA(0, 0, At, B0); PG8_MMA(0, 1, At, B1); PG8_BAR; PG8_SCHED;
            PG8_LDA(At, 1, 1); PG8_STAGE(PG8_SB(1, 0), b3, voffB); PG8_STAGE(PG8_SB(1, 1), b3 + hstep, voffB); PG8_STAGE(PG8_SA(1, 0), a3, voffA);
            PG8_WAIT_V(8); PG8_WAIT_L(0); PG8_BAR; PG8_MMA(1, 0, At, B0); PG8_MMA(1, 1, At, B1); PG8_BAR; PG8_SCHED;
            } else {
            PG8_LDB(B0, 0, 0); PG8_SCHED; PG8_LDA(At, 0, 0); PG8_STAGE(PG8_SA(1, 1), a1 + hstep, voffA);
            PG8_WAIT_L(8); PG8_BAR; PG8_WAIT_L(0); PG8_MMA(0, 0, At, B0); PG8_BAR; PG8_SCHED;
            PG8_LDB(B1, 0, 1); PG8_STAGE(PG8_SB(0, 0), b2, voffB);
            PG8_BAR; PG8_WAIT_L(0); PG8_MMA(0, 1, At, B1); PG8_BAR;
            PG8_LDA(At, 0, 1); PG8_STAGE(PG8_SA(0, 0), a2, voffA);
            PG8_BAR; PG8_WAIT_L(0); PG8_MMA(1, 0, At, B0); PG8_BAR; PG8_SCHED;
            PG8_STAGE(PG8_SB(0, 1), b2 + hstep, voffB);
            PG8_WAIT_V(6); PG8_BAR; PG8_MMA(1, 1, At, B1); PG8_BAR;
            PG8_LDB(B0, 1, 0); PG8_SCHED; PG8_LDA(At, 1, 0); PG8_STAGE(PG8_SA(0, 1), a2 + hstep, voffA);
            PG8_WAIT_L(8); PG8_BAR; PG8_WAIT_L(0); PG8_MMA(0, 0, At, B0); PG8_BAR; PG8_SCHED;
            PG8_LDB(B1, 1, 1); PG8_STAGE(PG8_SB(1, 0), b3, voffB);
            PG8_BAR; PG8_WAIT_L(0); PG8_MMA(0, 1, At, B1); PG8_BAR;
            PG8_LDA(At, 1, 1); PG8_STAGE(PG8_SA(1, 0), a3, voffA);
            PG8_BAR; PG8_WAIT_L(0); PG8_MMA(1, 0, At, B0); PG8_BAR; PG8_SCHED;
            PG8_STAGE(PG8_SB(1, 1), b3 + hstep, voffB);
            PG8_WAIT_V(6); PG8_BAR; PG8_MMA(1, 1, At, B1); PG8_BAR;
            }
        }
        if constexpr (ALIGN_EPI) { if (wr == 0) PG8_BAR; }
        cur.ord = ui;
        bool keep = false;
        if constexpr (!Epi::AFTER_DRAIN) { if constexpr (Epi::CHAIN) keep = E.chain(acc, cur, wr, wc, fr, fq); else E(acc, cur, wr, wc, fr, fq, pre); S.done(cur);
#if EPI_DRAIN
            asm volatile("s_waitcnt vmcnt(0)" ::: "memory");
#endif
        }
        if (!has_next) break;
        if (!keep)
#pragma unroll
        for (int a = 0; a < 2; ++a)
#pragma unroll
            for (int b = 0; b < 2; ++b)
#pragma unroll
                for (int m = 0; m < 4; ++m)
#pragma unroll
                    for (int n = 0; n < 2; ++n) acc[a][b][m][n] = (f32x4){0.f, 0.f, 0.f, 0.f};
        cur = nxt; cA = nA; cB = nB; ++ui;
        if constexpr (ALIGN_EPI) { if (wr == 1) PG8_BAR; }
    }
    PG8_WAIT_V(0);
    if constexpr (!ALIGN_EPI) { if (wr == 0) PG8_BAR; }
    PG8_BAR;
    if constexpr (Epi::AFTER_DRAIN) { E.fused(acc, cur, wr, wc, fr, fq, lds, wid, lane); S.done(cur); }
#undef PG8_KO
#undef PG8_SA
#undef PG8_SB
#undef PG8_STAGE
#undef PG8_LDA
#undef PG8_LDB
#undef PG8_MMA
#undef PG8_WAIT_V
#undef PG8_WAIT_L
#undef PG8_BAR
#undef PG8_SCHED
}
}

constexpr int NWAVES = 8;
constexpr int BATCH = 2, SEQ = 8192, D = 2048, DEPTH = 4, M = BATCH * SEQ;
constexpr int NH = 8, HD = 128, SBW = 1024, SGW = 1024, NG = 8, GD = 128, SL = 128, DFF = 8192, INC = 9216;
constexpr int C_Q = 0, C_K = 1024, C_V = 2048, C_U = 3072, C_VS = 4096, C_GA = 5120, C_GB = 7168;
constexpr float EPS = 1e-6f;
constexpr float SB_STOP = -44.0f;

constexpr size_t MiB = 1u << 20;
constexpr size_t WS_CTL = 0, CTL_ZERO_BYTES = 4 * MiB;
constexpr size_t WS_RS = 1 * MiB;
constexpr size_t WS_WIN = 4 * MiB;
constexpr size_t WS_WOAB = WS_WIN + 4 * 36 * MiB;
constexpr size_t WS_WOUT = WS_WOAB + 4 * 8 * MiB;
constexpr size_t WS_W1 = WS_WOUT + 4 * 8 * MiB;
constexpr size_t WS_W2 = WS_W1 + 4 * 32 * MiB;
constexpr size_t WS_WSP = WS_W2 + 4 * 32 * MiB;
constexpr size_t WS_XB = WS_WSP + 2 * MiB;
constexpr size_t WS_PROJ = WS_XB + 64 * MiB;
constexpr size_t WS_OS = WS_PROJ + 288 * MiB;
constexpr size_t WS_T = WS_OS + 64 * MiB;
constexpr size_t WS_MG = WS_T + 128 * MiB;
constexpr size_t WS_END = WS_MG + 64 * MiB;
constexpr size_t WS_XB8 = WS_T;
constexpr size_t WS_WIN8 = WS_T + 32 * MiB;
constexpr size_t WS_SWIN = WS_T + 104 * MiB;
constexpr size_t WS_SX = WS_T + 105 * MiB;
constexpr size_t WS_G8 = WS_W1;
constexpr size_t WS_W18 = WS_WIN;
constexpr size_t WS_SW1 = WS_WIN + 64 * MiB;
constexpr size_t WS_WOUT8 = WS_WIN + 66 * MiB;
constexpr size_t WS_SWOUT = WS_WIN + 82 * MiB;
static_assert((size_t)DEPTH * INC * D * 2 == 4 * 36 * MiB && (size_t)M * INC * 2 == 288 * MiB && (size_t)M * D * 4 == 128 * MiB, "d_ws map");
constexpr int CW_TMO = 0, CW_CODE = 1;
constexpr int CW_BAR = 4096;

constexpr int RING_OFF = 0, RING_BYTES = 131072;
constexpr int SCR_BYTES = 143360;
constexpr int LDSCTL_OFF = SCR_BYTES, MISC_OFF = LDSCTL_OFF + 320;
constexpr int LDS_BYTES = 147456;
static_assert(MISC_OFF + 128 <= LDS_BYTES, "LDS map");

#define GAS __attribute__((address_space(1)))
#define LAS __attribute__((address_space(3)))
typedef unsigned short bf16;
typedef unsigned v4u __attribute__((ext_vector_type(4)));
typedef unsigned v2u __attribute__((ext_vector_type(2)));
typedef float f32x4 __attribute__((ext_vector_type(4)));
typedef float f32x2 __attribute__((ext_vector_type(2)));
typedef float f32x16 __attribute__((ext_vector_type(16)));
typedef short bf16x8 __attribute__((ext_vector_type(8)));
typedef short s16x4 __attribute__((ext_vector_type(4)));
typedef GAS unsigned gu32;
#define RLX_AGENT __ATOMIC_RELAXED, __HIP_MEMORY_SCOPE_AGENT
#define LDS_WAIT() asm volatile("s_waitcnt lgkmcnt(0)" ::: "memory")
#define VM_WAIT() asm volatile("s_waitcnt vmcnt(0)" ::: "memory")
__device__ __forceinline__ unsigned f2bf(float f) { unsigned u = __builtin_bit_cast(unsigned, f); return (u + 0x7fffu + ((u >> 16) & 1u)) >> 16; }
__device__ __forceinline__ unsigned pk2(float lo, float hi) { return f2bf(lo) | (f2bf(hi) << 16); }
__device__ __forceinline__ float bflo(unsigned w) { return __uint_as_float(w << 16); }
__device__ __forceinline__ float bfhi(unsigned w) { return __uint_as_float(w & 0xffff0000u); }

#define XB_TMO      128
#define XB_XCNT(j)  (256  + 64 * (j))
#define XB_XSUB(j)  (1280 + 64 * (j))
#define XB_XGEN(j)  (2304 + 64 * (j))
#define XB_TOP      3328
#define XB_TOPGEN   3392
#define XCD_BAR_WORDS 3456
#define XB_SPIN_CAP (1u << 18)

__device__ __forceinline__ unsigned xb_ld(unsigned* p)              { return __hip_atomic_load(p, __ATOMIC_RELAXED, __HIP_MEMORY_SCOPE_AGENT); }
__device__ __forceinline__ unsigned xb_add(unsigned* p, unsigned v) { return __hip_atomic_fetch_add(p, v, __ATOMIC_RELAXED, __HIP_MEMORY_SCOPE_AGENT); }
__device__ __forceinline__ unsigned xb_xcc_id() { return (unsigned)__builtin_amdgcn_s_getreg((3 << 11) | 20) & 0xFu; }
#define XB_SPIN(cond, bar) do { unsigned _sp = 0; while (cond) { __builtin_amdgcn_s_sleep(1); \
    if ((++_sp & 255u) == 0u) { if (xb_ld(&(bar)[XB_TMO])) break; if (_sp > XB_SPIN_CAP) { atomicAdd(&(bar)[XB_TMO], 1u); break; } } } } while (0)

struct XcdBarrier {
    unsigned* bar; unsigned x;
    volatile LAS unsigned* st;
};

__device__ __forceinline__ XcdBarrier xcd_barrier_post(unsigned* bar, volatile LAS unsigned* st) {
    XcdBarrier b; b.bar = bar; b.x = xb_xcc_id(); b.st = st;
    if (threadIdx.x == 0) (void)xb_add(&bar[XB_XCNT(b.x)], 1u);
    return b;
}
__device__ __forceinline__ void xcd_barrier_complete(unsigned* bar, unsigned x, unsigned& nloc, unsigned& nx) {
    const unsigned G = gridDim.x * gridDim.y * gridDim.z;
    unsigned sum, cnt, mine, sp = 0u;
    for (;;) {
        sum = 0u; cnt = 0u; mine = 0u;
#pragma unroll
        for (unsigned j = 0; j < 16; ++j) { const unsigned c = xb_ld(&bar[XB_XCNT(j)]); sum += c; cnt += (c > 0u) ? 1u : 0u; mine = (j == x) ? c : mine; }
        if (sum == G) break;
        __builtin_amdgcn_s_sleep(1);
        if ((++sp & 255u) == 0u) { if (xb_ld(&bar[XB_TMO])) break; if (sp > XB_SPIN_CAP) { atomicAdd(&bar[XB_TMO], 1u); break; } }
    }
    nloc = mine > 0u ? mine : 1u; nx = cnt > 0u ? cnt : 1u;
}

__device__ __forceinline__ void xcd_barrier(const XcdBarrier& b) {
    asm volatile("s_waitcnt vmcnt(0)" ::: "memory");
    __syncthreads();
    if (threadIdx.x == 0) {
        unsigned* bar = b.bar;
        __builtin_amdgcn_s_waitcnt(0);
        unsigned nloc = b.st[0], nx = b.st[1];
        if (nloc == 0u) { xcd_barrier_complete(bar, b.x, nloc, nx); b.st[0] = nloc; b.st[1] = nx; }
        const unsigned old = xb_add(&bar[XB_XSUB(b.x)], 1u);
        const unsigned gen = old / nloc;
        if (old + 1u == (gen + 1u) * nloc) {
            __builtin_amdgcn_fence(__ATOMIC_RELEASE, "agent");
            asm volatile("s_waitcnt vmcnt(0)" ::: "memory");
            const unsigned og = xb_add(&bar[XB_TOP], 1u);
            const unsigned tg = og / nx;
            if (og + 1u == (tg + 1u) * nx) xb_add(&bar[XB_TOPGEN], 1u);
            else XB_SPIN(xb_ld(&bar[XB_TOPGEN]) == tg, bar);
            __builtin_amdgcn_fence(__ATOMIC_ACQUIRE, "agent");
            xb_add(&bar[XB_XGEN(b.x)], 1u);
            asm volatile("s_waitcnt vmcnt(0)" ::: "memory");
        } else {
            XB_SPIN(xb_ld(&bar[XB_XGEN(b.x)]) == gen, bar);
            __builtin_amdgcn_fence(__ATOMIC_ACQUIRE, "agent");
            asm volatile("s_waitcnt vmcnt(0)" ::: "memory");
        }
    }
    __syncthreads();
}

struct Frame {
    LAS unsigned char* lds;
    volatile LAS unsigned* MISC;
    gu32* ctl;
    int tid, lane, wave;
    int vcu, G;
};
__device__ __forceinline__ float wave_sum(float v) {
#pragma unroll
    for (int o = 1; o < 64; o <<= 1) v += __shfl_xor(v, o);
    return v;
}

struct Args { const float* in[15]; float* out; unsigned char* ws; int ph_lo, ph_hi; };
template <int K, int N> __device__ __forceinline__ void tr_load(const float* W, const float* gain, int item, int lane, f32x4 (&v)[8]) {
    constexpr int nblk = N / 32; const int kq = item / nblk, nb = item % nblk, k8 = 64 * kq + 8 * (lane & 7), n4 = 32 * nb + 4 * (lane >> 3);
    const float* src = W + (size_t)k8 * N + n4;
#pragma unroll
    for (int e = 0; e < 8; ++e) v[e] = *(const GAS f32x4*)(src + (size_t)e * N);
    if (gain) { const f32x4 g0 = *(const GAS f32x4*)(gain + k8), g1 = *(const GAS f32x4*)(gain + k8 + 4);
        v[0] = v[0] * g0.x; v[1] = v[1] * g0.y; v[2] = v[2] * g0.z; v[3] = v[3] * g0.w; v[4] = v[4] * g1.x; v[5] = v[5] * g1.y; v[6] = v[6] * g1.z; v[7] = v[7] * g1.w; }
}
template <int K, int N> __device__ __forceinline__ void tr_store(bf16* WT, int item, int lane, const f32x4 (&v)[8]) {
    constexpr int nblk = N / 32; const int kq = item / nblk, nb = item % nblk, k8 = 64 * kq + 8 * (lane & 7), n4 = 32 * nb + 4 * (lane >> 3);
    bf16* dst = WT + (size_t)n4 * K + k8;
#pragma unroll
    for (int j = 0; j < 4; ++j) { v4u o; o.x = pk2(v[0][j], v[1][j]); o.y = pk2(v[2][j], v[3][j]); o.z = pk2(v[4][j], v[5][j]); o.w = pk2(v[6][j], v[7][j]); *(GAS v4u*)(dst + (size_t)j * K) = o; }
}
template <int K, int N> __device__ __forceinline__ int convert_matrix(const float* W, const float* gain, bf16* WT, int slot, int nslot, int first, int lane) {
    constexpr int NI = (K / 64) * (N / 32);
    int s0 = slot - first; if (s0 < 0) s0 += nslot;
    for (int it = s0; it < NI; it += 2 * nslot) {
        f32x4 v0[8], v1[8]; tr_load<K, N>(W, gain, it, lane, v0);
        const bool two = it + nslot < NI;
        if (two) tr_load<K, N>(W, gain, it + nslot, lane, v1);
        tr_store<K, N>(WT, it, lane, v0);
        if (two) tr_store<K, N>(WT, it + nslot, lane, v1);
    }
    return (first + NI) % nslot;
}
template <int K, int N> __device__ __forceinline__ void quant_weights_i8(Frame& F, const float* W, const float* gain, signed char* W8, float* sw, LAS float* cm) {
    static_assert(K == 2048 && N % 32 == 0, "quant_weights_i8 geometry: K / 8 waves / 64 rows = 4 register chunks per wave");
    const int lane = F.lane, w = F.wave, g4 = lane >> 3, kb = lane & 7; constexpr int KW = K / NWAVES, NC = KW / 64;
    for (int it = F.vcu; it < N / 32; it += F.G) {
        const int n4 = 32 * it + 4 * g4;
        f32x4 v[NC][8];
#pragma unroll
        for (int c = 0; c < NC; ++c) { const int k8 = w * KW + 64 * c + 8 * kb; const float* src = W + (size_t)k8 * N + n4;
#pragma unroll
            for (int e = 0; e < 8; ++e) v[c][e] = *(const GAS f32x4*)(src + (size_t)e * N); }
        float m0 = 0.f, m1 = 0.f, m2 = 0.f, m3 = 0.f;
#pragma unroll
        for (int c = 0; c < NC; ++c) { const int k8 = w * KW + 64 * c + 8 * kb;
            f32x4 ga = {1.f, 1.f, 1.f, 1.f}, gb = ga; if (gain) { ga = *(const GAS f32x4*)(gain + k8); gb = *(const GAS f32x4*)(gain + k8 + 4); }
            v[c][0] = v[c][0] * ga.x; v[c][1] = v[c][1] * ga.y; v[c][2] = v[c][2] * ga.z; v[c][3] = v[c][3] * ga.w; v[c][4] = v[c][4] * gb.x; v[c][5] = v[c][5] * gb.y; v[c][6] = v[c][6] * gb.z; v[c][7] = v[c][7] * gb.w;
#pragma unroll
            for (int e = 0; e < 8; ++e) { m0 = fmaxf(m0, fabsf(v[c][e].x)); m1 = fmaxf(m1, fabsf(v[c][e].y)); m2 = fmaxf(m2, fabsf(v[c][e].z)); m3 = fmaxf(m3, fabsf(v[c][e].w)); } }
#pragma unroll
        for (int o = 1; o < 8; o <<= 1) { m0 = fmaxf(m0, __shfl_xor(m0, o)); m1 = fmaxf(m1, __shfl_xor(m1, o)); m2 = fmaxf(m2, __shfl_xor(m2, o)); m3 = fmaxf(m3, __shfl_xor(m3, o)); }
        __syncthreads();
        if (kb == 0) *(LAS f32x4*)(cm + w * 32 + 4 * g4) = (f32x4){m0, m1, m2, m3};
        __syncthreads();
        f32x4 cmax = *(const LAS f32x4*)(cm + 4 * g4);
#pragma unroll
        for (int ww = 1; ww < NWAVES; ++ww) { const f32x4 o = *(const LAS f32x4*)(cm + ww * 32 + 4 * g4); cmax.x = fmaxf(cmax.x, o.x); cmax.y = fmaxf(cmax.y, o.y); cmax.z = fmaxf(cmax.z, o.z); cmax.w = fmaxf(cmax.w, o.w); }
        const f32x4 inv = {cmax.x > 0.f ? 127.f / cmax.x : 0.f, cmax.y > 0.f ? 127.f / cmax.y : 0.f, cmax.z > 0.f ? 127.f / cmax.z : 0.f, cmax.w > 0.f ? 127.f / cmax.w : 0.f};
        if (w == 0 && kb == 0) *(GAS f32x4*)(sw + n4) = cmax * (1.0f / 127.0f);
#pragma unroll
        for (int c = 0; c < NC; ++c) { const int k8 = w * KW + 64 * c + 8 * kb;
            int q[4][8];
#pragma unroll
            for (int e = 0; e < 8; ++e) { const f32x4 t = v[c][e] * inv;
                q[0][e] = (int)__builtin_rintf(t.x); q[1][e] = (int)__builtin_rintf(t.y); q[2][e] = (int)__builtin_rintf(t.z); q[3][e] = (int)__builtin_rintf(t.w); }
#pragma unroll
            for (int j = 0; j < 4; ++j) { v2u o;
                o.x = (unsigned)(q[j][0] & 255) | ((unsigned)(q[j][1] & 255) << 8) | ((unsigned)(q[j][2] & 255) << 16) | ((unsigned)(q[j][3] & 255) << 24);
                o.y = (unsigned)(q[j][4] & 255) | ((unsigned)(q[j][5] & 255) << 8) | ((unsigned)(q[j][6] & 255) << 16) | ((unsigned)(q[j][7] & 255) << 24);
                *(GAS v2u*)(W8 + (size_t)(n4 + j) * K + k8) = o; } }
    }
    __syncthreads();
}
__device__ __forceinline__ void quant_panel_i8(Frame& F, const bf16* XBp, signed char* X8p, float* sxp, const unsigned long long* rowsq_p, const int row0, const int nrows) {
    const int lane = F.lane;
    for (int rb4 = 0; rb4 < nrows; rb4 += 4) {
        v4u a[4][2];
#pragma unroll
        for (int i = 0; i < 4; ++i) { const bf16* src = XBp + (size_t)(row0 + rb4 + i) * D + 32 * lane; a[i][0] = *(const GAS v4u*)src; a[i][1] = *(const GAS v4u*)(src + 8); }
        v4u b[4][2];
#pragma unroll
        for (int i = 0; i < 4; ++i) { const bf16* src = XBp + (size_t)(row0 + rb4 + i) * D + 32 * lane + 16; b[i][0] = *(const GAS v4u*)src; b[i][1] = *(const GAS v4u*)(src + 8); }
#pragma unroll
        for (int i = 0; i < 4; ++i) { const int r = row0 + rb4 + i;
            const unsigned wds[16] = {a[i][0].x, a[i][0].y, a[i][0].z, a[i][0].w, a[i][1].x, a[i][1].y, a[i][1].z, a[i][1].w, b[i][0].x, b[i][0].y, b[i][0].z, b[i][0].w, b[i][1].x, b[i][1].y, b[i][1].z, b[i][1].w};
            float mx = 0.f;
#pragma unroll
            for (int e = 0; e < 16; ++e) mx = fmaxf(mx, fmaxf(fabsf(bflo(wds[e])), fabsf(bfhi(wds[e]))));
#pragma unroll
            for (int o = 1; o < 64; o <<= 1) mx = fmaxf(mx, __shfl_xor(mx, o));
            const float inv = mx > 0.f ? 127.f / mx : 0.f, step = mx * (1.0f / 127.0f);
            unsigned qo[8];
#pragma unroll
            for (int e = 0; e < 8; ++e) { const int q0 = (int)__builtin_rintf(bflo(wds[2 * e]) * inv), q1 = (int)__builtin_rintf(bfhi(wds[2 * e]) * inv), q2 = (int)__builtin_rintf(bflo(wds[2 * e + 1]) * inv), q3 = (int)__builtin_rintf(bfhi(wds[2 * e + 1]) * inv);
                qo[e] = (unsigned)(q0 & 255) | ((unsigned)(q1 & 255) << 8) | ((unsigned)(q2 & 255) << 16) | ((unsigned)(q3 & 255) << 24); }
            signed char* dst = X8p + (size_t)r * D + 32 * lane;
            *(GAS v4u*)dst = (v4u){qo[0], qo[1], qo[2], qo[3]}; *(GAS v4u*)(dst + 16) = (v4u){qo[4], qo[5], qo[6], qo[7]};
            if (lane == 0) sxp[r] = rowsq_p ? __builtin_amdgcn_rsqf((float)rowsq_p[r] * (1.0f / (2048.0f * 16777216.0f)) + 1e-6f) * step : step; }
    }
}
template <bool HASY> __device__ __forceinline__ void quant_panel_f32(Frame& F, const float* Xp, const bf16* Yp, signed char* X8p, float* sxp, const int row0, const int nrows) {
    const int lane = F.lane;
    constexpr int RB = HASY ? 2 : 4;
    for (int rb = 0; rb < nrows; rb += RB) {
        f32x4 v[RB][8]; v4u yv[RB][4];
#pragma unroll
        for (int i = 0; i < RB; ++i) { const float* src = Xp + (size_t)(row0 + rb + i) * D + 8 * lane;
#pragma unroll
            for (int j = 0; j < 4; ++j) { v[i][2 * j] = *(const GAS f32x4*)(src + 512 * j); v[i][2 * j + 1] = *(const GAS f32x4*)(src + 512 * j + 4); }
            if constexpr (HASY) { const bf16* ys = Yp + (size_t)(row0 + rb + i) * D + 8 * lane;
#pragma unroll
                for (int j = 0; j < 4; ++j) yv[i][j] = *(const GAS v4u*)(ys + 512 * j); } }
#pragma unroll
        for (int i = 0; i < RB; ++i) { const int r = row0 + rb + i; float mx = 0.f, ss = 0.f;
            if constexpr (HASY) {
#pragma unroll
                for (int j = 0; j < 4; ++j) { const v4u w = yv[i][j]; v[i][2 * j] = v[i][2 * j] + (f32x4){bflo(w.x), bfhi(w.x), bflo(w.y), bfhi(w.y)}; v[i][2 * j + 1] = v[i][2 * j + 1] + (f32x4){bflo(w.z), bfhi(w.z), bflo(w.w), bfhi(w.w)}; } }
#pragma unroll
            for (int j = 0; j < 8; ++j) { const f32x4 t = v[i][j]; mx = fmaxf(fmaxf(mx, fmaxf(fabsf(t.x), fabsf(t.y))), fmaxf(fabsf(t.z), fabsf(t.w))); ss += (t.x * t.x + t.y * t.y) + (t.z * t.z + t.w * t.w); }
#pragma unroll
            for (int o = 1; o < 64; o <<= 1) mx = fmaxf(mx, __shfl_xor(mx, o));
            ss = wave_sum(ss);
            const float inv = mx > 0.f ? 127.f / mx : 0.f, step = mx * (1.0f / 127.0f);
            signed char* dst = X8p + (size_t)r * D + 8 * lane;
#pragma unroll
            for (int j = 0; j < 4; ++j) { const f32x4 t0 = v[i][2 * j] * inv, t1 = v[i][2 * j + 1] * inv;
                const int q0 = (int)__builtin_rintf(t0.x), q1 = (int)__builtin_rintf(t0.y), q2 = (int)__builtin_rintf(t0.z), q3 = (int)__builtin_rintf(t0.w), q4 = (int)__builtin_rintf(t1.x), q5 = (int)__builtin_rintf(t1.y), q6 = (int)__builtin_rintf(t1.z), q7 = (int)__builtin_rintf(t1.w);
                v2u o; o.x = (unsigned)(q0 & 255) | ((unsigned)(q1 & 255) << 8) | ((unsigned)(q2 & 255) << 16) | ((unsigned)(q3 & 255) << 24); o.y = (unsigned)(q4 & 255) | ((unsigned)(q5 & 255) << 8) | ((unsigned)(q6 & 255) << 16) | ((unsigned)(q7 & 255) << 24);
                *(GAS v2u*)(dst + 512 * j) = o; }
            if (lane == 0) sxp[r] = __builtin_amdgcn_rsqf(ss * (1.0f / 2048.0f) + 1e-6f) * step; }
    }
}
__device__ __forceinline__ int convert_win(const Args& a, unsigned char* ws, int l, int slot, int nslot, int lane, int f) {
    bf16* Win = (bf16*)(ws + WS_WIN);
    return convert_matrix<D, INC>(a.in[2] + (size_t)l * D * INC, a.in[1] + l * D, Win + (size_t)l * INC * D, slot, nslot, f, lane);
}
__device__ __forceinline__ int convert_rest(const Args& a, unsigned char* ws, int l, int slot, int nslot, int lane, int f) {
    bf16* Woab = (bf16*)(ws + WS_WOAB); bf16* Wout = (bf16*)(ws + WS_WOUT); bf16* W1 = (bf16*)(ws + WS_W1); bf16* W2 = (bf16*)(ws + WS_W2);
    f = convert_matrix<SBW, D>(a.in[9] + (size_t)l * SBW * D, nullptr, Woab + (size_t)l * 4096 * 1024, slot, nslot, f, lane);
    f = convert_matrix<SGW, D>(a.in[10] + (size_t)l * SGW * D, nullptr, Woab + (size_t)l * 4096 * 1024 + (size_t)2048 * 1024, slot, nslot, f, lane);
#if !I8_OUT
    f = convert_matrix<D, D>(a.in[11] + (size_t)l * D * D, nullptr, Wout + (size_t)l * D * D, slot, nslot, f, lane);
#endif
#if !I8_FF1
    f = convert_matrix<D, DFF>(a.in[13] + (size_t)l * D * DFF, a.in[12] + l * D, W1 + (size_t)l * DFF * D, slot, nslot, f, lane);
#endif
    f = convert_matrix<DFF, D>(a.in[14] + (size_t)l * DFF * D, nullptr, W2 + (size_t)l * D * DFF, slot, nslot, f, lane);
    return f;
}
__device__ __forceinline__ void convert_layer(const Args& a, unsigned char* ws, int l, int slot, int nslot, int lane) {
    int f = convert_rest(a, ws, l, slot, nslot, lane, 0);
#if !I8_INPROJ
    if (l + 1 < DEPTH) convert_win(a, ws, l + 1, slot, nslot, lane, f);
#endif
}
template <int L, int BASE> struct ConvSide {
    struct State { f32x4 v[8]; f32x4 g0, g1; bf16* dst; int K; };
    __device__ __forceinline__ void begin(int ord, int lane, State& st) const {
        constexpr int I_IN = (D / 64) * (INC / 32), I_OA = (SBW / 64) * (D / 32), I_OUT = (D / 64) * (D / 32), I_1 = (D / 64) * (DFF / 32), I_2 = (DFF / 64) * (D / 32);
        constexpr int I_LAYER = I_IN + 2 * I_OA + I_OUT + I_1 + I_2;
        const int G = (int)gridDim.x, bx = (int)blockIdx.x, vcu = (G % 8 == 0) ? (bx % 8) * (G / 8) + bx / 8 : bx;
        const int slot = vcu * NWAVES + __builtin_amdgcn_readfirstlane((int)(threadIdx.x >> 6)), nslot = G * NWAVES;
        int r = (slot + (BASE + ord) * nslot) % I_LAYER;
        const __attribute__((address_space(4))) Args* a = (const __attribute__((address_space(4))) Args*)__builtin_amdgcn_kernarg_segment_ptr();
        unsigned char* ws = a->ws;
        const float* W; const float* gain = nullptr; bf16* WT; int K, N, kq, nb;
        if (r < I_IN) { W = a->in[2] + (size_t)L * D * INC; gain = a->in[1] + L * D; WT = (bf16*)(ws + WS_WIN) + (size_t)L * INC * D; K = D; N = INC; kq = r / (INC / 32); nb = r % (INC / 32); }
        else if ((r -= I_IN) < I_1) { W = a->in[13] + (size_t)L * D * DFF; gain = a->in[12] + L * D; WT = (bf16*)(ws + WS_W1) + (size_t)L * DFF * D; K = D; N = DFF; kq = r / (DFF / 32); nb = r % (DFF / 32); }
        else if ((r -= I_1) < I_2) { W = a->in[14] + (size_t)L * DFF * D; WT = (bf16*)(ws + WS_W2) + (size_t)L * D * DFF; K = DFF; N = D; kq = r / (D / 32); nb = r % (D / 32); }
        else if ((r -= I_2) < I_OUT) { W = a->in[11] + (size_t)L * D * D; WT = (bf16*)(ws + WS_WOUT) + (size_t)L * D * D; K = D; N = D; kq = r / (D / 32); nb = r % (D / 32); }
        else if ((r -= I_OUT) < I_OA) { W = a->in[9] + (size_t)L * SBW * D; WT = (bf16*)(ws + WS_WOAB) + (size_t)L * 4096 * 1024; K = SBW; N = D; kq = r / (D / 32); nb = r % (D / 32); }
        else { r -= I_OA; W = a->in[10] + (size_t)L * SGW * D; WT = (bf16*)(ws + WS_WOAB) + (size_t)L * 4096 * 1024 + (size_t)2048 * 1024; K = SGW; N = D; kq = r / (D / 32); nb = r % (D / 32); }
        const int k8 = 64 * kq + 8 * (lane & 7), n4 = 32 * nb + 4 * (lane >> 3);
        const float* src = W + (size_t)k8 * N + n4;
#pragma unroll
        for (int e = 0; e < 8; ++e) st.v[e] = *(const GAS f32x4*)(src + (size_t)e * N);
        if (gain) { st.g0 = *(const GAS f32x4*)(gain + k8); st.g1 = *(const GAS f32x4*)(gain + k8 + 4); } else { st.g0 = (f32x4){1.f, 1.f, 1.f, 1.f}; st.g1 = st.g0; }
        st.dst = WT + (size_t)n4 * K + k8; st.K = K;
    }
    __device__ __forceinline__ void end(int lane, State& st) const {
        const f32x4 v0 = st.v[0] * st.g0.x, v1 = st.v[1] * st.g0.y, v2 = st.v[2] * st.g0.z, v3 = st.v[3] * st.g0.w, v4 = st.v[4] * st.g1.x, v5 = st.v[5] * st.g1.y, v6 = st.v[6] * st.g1.z, v7 = st.v[7] * st.g1.w;
#pragma unroll
        for (int j = 0; j < 4; ++j) { v4u o; o.x = pk2(v0[j], v1[j]); o.y = pk2(v2[j], v3[j]); o.z = pk2(v4[j], v5[j]); o.w = pk2(v6[j], v7[j]); *(GAS v4u*)(st.dst + (size_t)j * st.K) = o; }
    }
};
__device__ __forceinline__ void p0_prologue(Frame& F, const Args& a, unsigned char* ws) {
    const int gw = F.vcu * NWAVES + F.wave, NGW = F.G * NWAVES;
    bf16* Wsp = (bf16*)(ws + WS_WSP);
#if I8_INPROJ
    for (int l = 0; l < DEPTH; ++l) quant_weights_i8<D, INC>(F, a.in[2] + (size_t)l * D * INC, a.in[1] + l * D, (signed char*)(ws + WS_WIN8) + (size_t)l * INC * D, (float*)(ws + WS_SWIN) + l * INC, (LAS float*)(F.lds));
#if I8_OUT
    for (int l = 0; l < DEPTH; ++l) quant_weights_i8<D, D>(F, a.in[11] + (size_t)l * D * D, nullptr, (signed char*)(ws + WS_WOUT8) + (size_t)l * D * D, (float*)(ws + WS_SWOUT) + l * D, (LAS float*)(F.lds));
#endif
#if I8_FF1
    for (int l = 0; l < DEPTH; ++l) quant_weights_i8<D, DFF>(F, a.in[13] + (size_t)l * D * DFF, a.in[12] + l * D, (signed char*)(ws + WS_W18) + (size_t)l * DFF * D, (float*)(ws + WS_SW1) + l * DFF, (LAS float*)(F.lds));
#endif
#else
    convert_win(a, ws, 0, gw, NGW, F.lane, 0);
#endif
    { const float* wsrc = a.in[7]; const int n = DEPTH * NG * SL * SL;
      for (int e = (F.vcu * NWAVES * 64 + F.tid) * 2; e < n; e += F.G * NWAVES * 64 * 2) { const int i = (e >> 7) & 127, j = e & 127; const bool keep = (j >> 6) <= (i >> 6);
          const f32x2 v = *(const GAS f32x2*)(wsrc + e); *(GAS unsigned*)(Wsp + e) = keep ? pk2(v.x, v.y) : 0u; } }
    if (!I8_INPROJ) { const float* x = a.in[0]; bf16* XB = (bf16*)(ws + WS_XB); unsigned long long* RS0 = (unsigned long long*)(ws + WS_RS);
      for (int m = gw; m < M; m += NGW) { const GAS f32x4* xr = (const GAS f32x4*)(x + (size_t)m * D) + F.lane; GAS v2u* o = (GAS v2u*)(XB + (size_t)m * D) + F.lane; float ss = 0.f;
#pragma unroll
          for (int j = 0; j < 8; ++j) { const f32x4 v = xr[64 * j]; ss += (v.x * v.x + v.y * v.y) + (v.z * v.z + v.w * v.w); v2u w; w.x = pk2(v.x, v.y); w.y = pk2(v.z, v.w); o[64 * j] = w; }
          ss = wave_sum(ss); if (F.lane == 0) RS0[m] = (unsigned long long)(ss * 16777216.0f + 0.5f); } }
}

__device__ __forceinline__ void attn_naive(Frame& F, const bf16* proj, bf16* O, const float* gq, const float* gk) {
    const int gw = F.vcu * NWAVES + F.wave, NGW = F.G * NWAVES; const int lane = F.lane;
    for (int u = gw; u < M * NH; u += NGW) {
        const int h = u & 7, row = u >> 3, t = row & (SEQ - 1), rb = row - t;
        const float gq0 = gq[h * HD + 2 * lane], gq1 = gq[h * HD + 2 * lane + 1], gk0 = gk[h * HD + 2 * lane], gk1 = gk[h * HD + 2 * lane + 1];
        const unsigned qw = *(const GAS unsigned*)(proj + (size_t)row * INC + C_Q + h * HD + 2 * lane);
        float q0 = bflo(qw), q1 = bfhi(qw);
        const float rq = 1.0f / sqrtf(wave_sum(q0 * q0 + q1 * q1) * (1.0f / HD) + EPS);
        q0 = q0 * rq * gq0 * 0.08838834764831845f; q1 = q1 * rq * gq1 * 0.08838834764831845f;
        float carry = 0.f, o0 = 0.f, o1 = 0.f;
        for (int s = t - 1; s >= 0; --s) {
            const bf16* kr = proj + (size_t)(rb + s) * INC + h * HD + 2 * lane;
            const unsigned kw = *(const GAS unsigned*)(kr + C_K), vw = *(const GAS unsigned*)(kr + C_V);
            const float k0 = bflo(kw), k1 = bfhi(kw);
            const float rk = 1.0f / sqrtf(wave_sum(k0 * k0 + k1 * k1) * (1.0f / HD) + EPS);
            const float z = wave_sum(q0 * k0 * gk0 + q1 * k1 * gk1) * rk;
            const float sp = fmaxf(z, 0.f) + log1pf(expf(-fabsf(z)));
            const float a = expf(z - sp + carry);
            o0 += a * bflo(vw); o1 += a * bfhi(vw);
            carry -= sp;
            if (carry < SB_STOP) break;
        }
        *(GAS unsigned*)(O + (size_t)row * SBW + h * HD + 2 * lane) = pk2(o0, o1);
    }
}
__device__ __forceinline__ void sgu_naive(Frame& F, const bf16* proj, bf16* S, const bf16* Wsp, const float* lng, const float* lnb, const float* bsp) {
    LAS float* vn = (LAS float*)F.lds;
    LAS float* st = (LAS float*)(F.lds + 65536);
    for (int u = F.vcu; u < (M / SL) * NG; u += F.G) {
        const int g = u & 7, r0 = (u >> 3) * SL;
        __syncthreads();
        for (int rr = 0; rr < 16; ++rr) { const int j = F.wave * 16 + rr; const bf16* vr = proj + (size_t)(r0 + j) * INC + C_VS + 16 * F.lane;
            const v4u a = *(const GAS v4u*)vr, b = *(const GAS v4u*)(vr + 8); const unsigned w[8] = {a.x, a.y, a.z, a.w, b.x, b.y, b.z, b.w}; float s1 = 0.f, s2 = 0.f;
#pragma unroll
            for (int e = 0; e < 8; ++e) { const float lo = bflo(w[e]), hi = bfhi(w[e]); s1 += lo + hi; s2 += lo * lo + hi * hi; }
            s1 = wave_sum(s1); s2 = wave_sum(s2); const float mu = s1 * (1.0f / SGW), var = fmaxf(s2 * (1.0f / SGW) - mu * mu, 0.f);
            if (F.lane == 0) { st[2 * j] = mu; st[2 * j + 1] = 1.0f / sqrtf(var + EPS); } }
        __syncthreads();
        for (int e = F.tid; e < SL * GD; e += NWAVES * 64) { const int j = e >> 7, d = e & 127; const unsigned short raw = proj[(size_t)(r0 + j) * INC + C_VS + g * GD + d];
            vn[e] = (__uint_as_float((unsigned)raw << 16) - st[2 * j]) * st[2 * j + 1] * lng[g * GD + d] + lnb[g * GD + d]; }
        __syncthreads();
        const int d = F.tid & 127, iq = F.tid >> 7;
        for (int ii = 0; ii < 32; ++ii) { const int i = iq * 32 + ii; const bf16* wr_ = Wsp + ((size_t)g * SL + i) * SL; float acc = 0.f;
            for (int j = 0; j < SL; ++j) acc += __uint_as_float((unsigned)wr_[j] << 16) * vn[j * GD + d];
            const float uu = __uint_as_float((unsigned)proj[(size_t)(r0 + i) * INC + C_U + g * GD + d] << 16);
            S[(size_t)(r0 + i) * SGW + g * GD + d] = (bf16)f2bf(uu * (acc + bsp[g * SL + i])); }
    }
    __syncthreads();
}

#define MFMA32(a, b, c) __builtin_amdgcn_mfma_f32_32x32x16_bf16((a), (b), (c), 0, 0, 0)
__device__ __forceinline__ s16x4 tr16(const LAS unsigned char* p) { return __builtin_bit_cast(s16x4, __builtin_amdgcn_ds_read_tr16_b64_v4i16((LAS s16x4*)p)); }
__device__ __forceinline__ unsigned cvtpk(float lo, float hi) { typedef __bf16 bf2 __attribute__((ext_vector_type(2))); const f32x2 v = {lo, hi}; return __builtin_bit_cast(unsigned, __builtin_convertvector(v, bf2)); }
constexpr int ATT_GG = 4096, ATT_WV = 8832;
__device__ __forceinline__ void attn_mfma(Frame& F, const bf16* proj, bf16* O, const float* gq, const float* gk, const Args& args, unsigned char* ws, int conv_l) {
    LAS float* gg = (LAS float*)F.lds;
    for (int e = F.tid; e < NH * HD; e += NWAVES * 64) gg[e] = gq[e] * gk[e];
    __syncthreads();
    LAS unsigned char* wl = F.lds + ATT_GG + F.wave * ATT_WV; LAS float* rkl = (LAS float*)(wl + 8704);
    const int lane = F.lane, c = lane & 31, hh = lane >> 5;
    const int gw = F.vcu * NWAVES + F.wave, NGW = F.G * NWAVES;
    const LAS unsigned char* trb = wl + (4 * hh + ((lane & 15) >> 2)) * 272 + (16 * ((lane >> 4) & 1) + 4 * (lane & 3)) * 2;
    LAS unsigned char* vst = wl + (lane >> 4) * 272 + (lane & 15) * 16;
    constexpr float LOG2E = 1.4426950408889634f;
    if (conv_l >= 0 && (F.wave & 4)) convert_layer(args, ws, conv_l, gw, NGW, lane);
    const bool mloc = MIX_LOCAL && F.G == 256 && BATCH * NH * (SEQ / 32) == 2 * NGW;
    for (int u_ = gw; u_ < BATCH * NH * (SEQ / 32); u_ += NGW) {
        int u = u_;
        if (mloc) { const int i_ = u_ / NGW, v_ = (u_ % NGW) >> 3, w_ = u_ & 7, P_ = 8 * (v_ >> 5) + (v_ & 7), k_ = (v_ & 31) >> 3; u = ((P_ >> 5) * NH + 2 * k_ + i_) * (SEQ / 32) + ((P_ & 31) << 3) + w_; }
        const int qt = u & (SEQ / 32 - 1), bh = u / (SEQ / 32), h = bh & (NH - 1), b = bh / NH;
        const int q0 = qt * 32; const size_t rb = (size_t)b * SEQ;
        v4u kw[8], vw[8];
#define ATT_LOAD_KV(KT) do { const int k0_ = (KT) * 32; const bf16* krow_ = proj + (rb + k0_ + c) * INC + C_K + h * HD + 8 * hh; const bf16* vrow_ = proj + (rb + k0_ + (lane >> 4)) * INC + C_V + h * HD + 8 * (lane & 15); \
            _Pragma("unroll") for (int ks_ = 0; ks_ < 8; ++ks_) kw[ks_] = *(const GAS v4u*)(krow_ + 16 * ks_); \
            _Pragma("unroll") for (int i_ = 0; i_ < 8; ++i_) vw[i_] = *(const GAS v4u*)(vrow_ + (size_t)(4 * i_) * INC); } while (0)
        ATT_LOAD_KV(qt);
        bf16x8 qf[8]; float ssq = 0.f;
        { const bf16* qrow = proj + (rb + q0 + c) * INC + C_Q + h * HD + 8 * hh; const LAS float* gr = gg + h * HD + 8 * hh;
#pragma unroll
          for (int ks = 0; ks < 8; ++ks) { const v4u w = *(const GAS v4u*)(qrow + 16 * ks); const f32x4 g0 = *(const LAS f32x4*)(gr + 16 * ks), g1 = *(const LAS f32x4*)(gr + 16 * ks + 4);
              const float x0 = bflo(w.x), x1 = bfhi(w.x), x2 = bflo(w.y), x3 = bfhi(w.y), x4 = bflo(w.z), x5 = bfhi(w.z), x6 = bflo(w.w), x7 = bfhi(w.w);
              ssq += (x0 * x0 + x1 * x1) + (x2 * x2 + x3 * x3) + (x4 * x4 + x5 * x5) + (x6 * x6 + x7 * x7);
              v4u p; p.x = cvtpk(x0 * g0.x, x1 * g0.y); p.y = cvtpk(x2 * g0.z, x3 * g0.w); p.z = cvtpk(x4 * g1.x, x5 * g1.y); p.w = cvtpk(x6 * g1.z, x7 * g1.w);
              qf[ks] = __builtin_bit_cast(bf16x8, p); } }
        ssq += __shfl_xor(ssq, 32);
        const float cq = __builtin_amdgcn_rsqf(ssq * (1.0f / HD) + EPS) * (0.08838834764831845f * LOG2E);
        f32x16 o0, o1, o2, o3;
#pragma unroll
        for (int r = 0; r < 16; ++r) { o0[r] = 0.f; o1[r] = 0.f; o2[r] = 0.f; o3[r] = 0.f; }
        float carry = 0.f;
        for (int kt = qt; ; --kt) {
            bf16x8 kf[8]; float ksq = 0.f;
#pragma unroll
            for (int ks = 0; ks < 8; ++ks) { const v4u w = kw[ks]; kf[ks] = __builtin_bit_cast(bf16x8, w);
                const float x0 = bflo(w.x), x1 = bfhi(w.x), x2 = bflo(w.y), x3 = bfhi(w.y), x4 = bflo(w.z), x5 = bfhi(w.z), x6 = bflo(w.w), x7 = bfhi(w.w);
                ksq += (x0 * x0 + x1 * x1) + (x2 * x2 + x3 * x3) + (x4 * x4 + x5 * x5) + (x6 * x6 + x7 * x7); }
#pragma unroll
            for (int i = 0; i < 8; ++i) *(LAS v4u*)(vst + i * 4 * 272) = vw[i];
            { const int kn = kt > 0 ? kt - 1 : 0; ATT_LOAD_KV(kn); }
            ksq += __shfl_xor(ksq, 32);
            if (hh == 0) rkl[c] = __builtin_amdgcn_rsqf(ksq * (1.0f / HD) + EPS);
            f32x16 s;
#pragma unroll
            for (int r = 0; r < 16; ++r) s[r] = 0.f;
#pragma unroll
            for (int ks = 0; ks < 8; ++ks) s = MFMA32(kf[ks], qf[ks], s);
            asm volatile("s_waitcnt lgkmcnt(0)" ::: "memory");
            const bool diag = (kt == qt);
            float lk[16];
#pragma unroll
            for (int jj = 0; jj < 4; ++jj) { const f32x4 rk4 = *(const LAS f32x4*)(rkl + 4 * hh + 8 * jj);
#pragma unroll
                for (int i = 0; i < 4; ++i) { const int r = 4 * jj + i; const float z = s[r] * cq * rk4[i];
                    const float sp = fmaxf(z, 0.f) + __builtin_amdgcn_logf(1.0f + __builtin_amdgcn_exp2f(-fabsf(z)));
                    const bool dead = diag && (i + 8 * jj + 4 * hh >= c);
                    s[r] = z; lk[r] = dead ? 0.f : -sp; } }
            float G[4], Gp[4];
#pragma unroll
            for (int jj = 0; jj < 4; ++jj) { G[jj] = (lk[4 * jj] + lk[4 * jj + 1]) + (lk[4 * jj + 2] + lk[4 * jj + 3]); Gp[jj] = __shfl_xor(G[jj], 32); }
            const float T0 = G[0] + Gp[0], T1 = G[1] + Gp[1], T2 = G[2] + Gp[2], T3 = G[3] + Gp[3];
            float aft[4]; aft[3] = carry; aft[2] = carry + T3; aft[1] = aft[2] + T2; aft[0] = aft[1] + T1;
#pragma unroll
            for (int jj = 0; jj < 4; ++jj) { float t = aft[jj] + (hh == 0 ? Gp[jj] : 0.f);
#pragma unroll
                for (int i = 3; i >= 0; --i) { const int r = 4 * jj + i; const bool dead = diag && (i + 8 * jj + 4 * hh >= c);
                    const float l = lk[r]; s[r] = dead ? 0.f : __builtin_amdgcn_exp2f(s[r] + l + t); t += l; } }
            carry = aft[0] + T0;
            bf16x8 pf[2];
#pragma unroll
            for (int st = 0; st < 2; ++st) { v4u p; p.x = cvtpk(s[8 * st], s[8 * st + 1]); p.y = cvtpk(s[8 * st + 2], s[8 * st + 3]); p.z = cvtpk(s[8 * st + 4], s[8 * st + 5]); p.w = cvtpk(s[8 * st + 6], s[8 * st + 7]);
                pf[st] = __builtin_bit_cast(bf16x8, p); }
#pragma unroll
            for (int st = 0; st < 2; ++st) {
#define VFRAG(db) ({ const s16x4 lo_ = tr16(trb + (16 * st) * 272 + (db) * 64), hi_ = tr16(trb + (16 * st + 8) * 272 + (db) * 64); \
                     (bf16x8){lo_[0], lo_[1], lo_[2], lo_[3], hi_[0], hi_[1], hi_[2], hi_[3]}; })
                o0 = MFMA32(VFRAG(0), pf[st], o0); o1 = MFMA32(VFRAG(1), pf[st], o1); o2 = MFMA32(VFRAG(2), pf[st], o2); o3 = MFMA32(VFRAG(3), pf[st], o3);
#undef VFRAG
            }
            if (kt == 0 || __all(carry < SB_STOP * LOG2E)) break;
        }
#undef ATT_LOAD_KV
        bf16* orow = O + (rb + q0 + c) * SBW + h * HD + 4 * hh;
#pragma unroll
        for (int jj = 0; jj < 4; ++jj) {
            v2u w; w.x = cvtpk(o0[4 * jj], o0[4 * jj + 1]); w.y = cvtpk(o0[4 * jj + 2], o0[4 * jj + 3]); *(GAS v2u*)(orow + 8 * jj) = w;
            w.x = cvtpk(o1[4 * jj], o1[4 * jj + 1]); w.y = cvtpk(o1[4 * jj + 2], o1[4 * jj + 3]); *(GAS v2u*)(orow + 32 + 8 * jj) = w;
            w.x = cvtpk(o2[4 * jj], o2[4 * jj + 1]); w.y = cvtpk(o2[4 * jj + 2], o2[4 * jj + 3]); *(GAS v2u*)(orow + 64 + 8 * jj) = w;
            w.x = cvtpk(o3[4 * jj], o3[4 * jj + 1]); w.y = cvtpk(o3[4 * jj + 2], o3[4 * jj + 3]); *(GAS v2u*)(orow + 96 + 8 * jj) = w; }
    }
    if (conv_l >= 0 && !(F.wave & 4)) convert_layer(args, ws, conv_l, gw, NGW, lane);
    __syncthreads();
}

constexpr int SGU_ST = 0, SGU_IMG = 1024, SGU_IMG_BYTES = 128 * 272;
__device__ __forceinline__ void sgu_mfma(Frame& F, const bf16* proj, bf16* S, const bf16* Wsp, const float* lng, const float* lnb, const float* bsp) {
    LAS f32x2* st = (LAS f32x2*)(F.lds + SGU_ST); LAS unsigned char* img = F.lds + SGU_IMG;
    const int lane = F.lane, c = lane & 31, hh = lane >> 5, w = F.wave;
    const int dblk = w & 3, ih = w >> 2;
    const LAS unsigned char* trb = img + (8 * hh + ((lane & 15) >> 2)) * 272 + (32 * dblk + 16 * ((lane >> 4) & 1) + 4 * (lane & 3)) * 2;
    for (int u_ = F.vcu; u_ < (M / SL) * 2; u_ += F.G) {
        int u = u_;
        if (MIX_LOCAL && F.G == 256) u = 4 * (8 * (u_ >> 5) + (u_ & 7)) + ((u_ & 31) >> 3);
        const int r0 = (u >> 1) * SL, g0 = (u & 1) * 4;
        __syncthreads();
        { v4u ra[16], rb2[16];
#pragma unroll
          for (int rr = 0; rr < 16; ++rr) { const bf16* vr = proj + (size_t)(r0 + w * 16 + rr) * INC + C_VS + 16 * lane; ra[rr] = *(const GAS v4u*)vr; rb2[rr] = *(const GAS v4u*)(vr + 8); }
#pragma unroll
          for (int rr = 0; rr < 16; ++rr) { const v4u a = ra[rr], b = rb2[rr];
              float s1 = ((bflo(a.x) + bfhi(a.x)) + (bflo(a.y) + bfhi(a.y))) + ((bflo(a.z) + bfhi(a.z)) + (bflo(a.w) + bfhi(a.w))) + ((bflo(b.x) + bfhi(b.x)) + (bflo(b.y) + bfhi(b.y))) + ((bflo(b.z) + bfhi(b.z)) + (bflo(b.w) + bfhi(b.w)));
              s1 = wave_sum(s1); const float mu = s1 * (1.0f / SGW);
              float s2 = 0.f;
#define SQ_(x) { const float d0_ = bflo(x) - mu, d1_ = bfhi(x) - mu; s2 += d0_ * d0_ + d1_ * d1_; }
              SQ_(a.x) SQ_(a.y) SQ_(a.z) SQ_(a.w) SQ_(b.x) SQ_(b.y) SQ_(b.z) SQ_(b.w)
#undef SQ_
              s2 = wave_sum(s2);
              if (lane == 0) st[w * 16 + rr] = (f32x2){mu, 1.0f / sqrtf(s2 * (1.0f / SGW) + EPS)}; } }
        __syncthreads();
        v4u vx[4];
#define SGU_LOAD_V(G) do { _Pragma("unroll") for (int i_ = 0; i_ < 4; ++i_) vx[i_] = *(const GAS v4u*)(proj + (size_t)(r0 + w * 16 + 4 * i_ + (lane >> 4)) * INC + C_VS + (G) * GD + 8 * (lane & 15)); } while (0)
        SGU_LOAD_V(g0);
        v4u bw[2][8];
#define SGU_LOAD_W(G) do { _Pragma("unroll") for (int it_ = 0; it_ < 2; ++it_) _Pragma("unroll") for (int s_ = 0; s_ < 8; ++s_) bw[it_][s_] = *(const GAS v4u*)(Wsp + ((size_t)(G) * SL + 64 * ih + 32 * it_ + c) * SL + 16 * s_ + 8 * hh); } while (0)
        SGU_LOAD_W(g0);
        f32x4 lg0, lg1, lb0, lb1;
#define SGU_LOAD_LN(G) do { const int ch_ = lane & 15; lg0 = *(const GAS f32x4*)(lng + (G) * GD + 8 * ch_); lg1 = *(const GAS f32x4*)(lng + (G) * GD + 8 * ch_ + 4); lb0 = *(const GAS f32x4*)(lnb + (G) * GD + 8 * ch_); lb1 = *(const GAS f32x4*)(lnb + (G) * GD + 8 * ch_ + 4); } while (0)
        SGU_LOAD_LN(g0);
#pragma unroll 1
        for (int gi = 0; gi < 4; ++gi) {
            const int g = g0 + gi; LAS unsigned char* im = img + (gi & 1) * SGU_IMG_BYTES;
            v2u uw[2][4]; float bias2[2];
#pragma unroll
            for (int it = 0; it < 2; ++it) { bias2[it] = bsp[g * SL + 64 * ih + 32 * it + c];
#pragma unroll
                for (int jj = 0; jj < 4; ++jj) uw[it][jj] = *(const GAS v2u*)(proj + (size_t)(r0 + 64 * ih + 32 * it + c) * INC + C_U + g * GD + 32 * dblk + 4 * hh + 8 * jj); }
            { const int ch = lane & 15;
#pragma unroll
              for (int i = 0; i < 4; ++i) { const int j = w * 16 + 4 * i + (lane >> 4); const v4u x = vx[i]; const f32x2 ms = st[j];
                  const float m_ = ms.x, r_ = ms.y;
                  v4u p; p.x = cvtpk((bflo(x.x) - m_) * r_ * lg0.x + lb0.x, (bfhi(x.x) - m_) * r_ * lg0.y + lb0.y); p.y = cvtpk((bflo(x.y) - m_) * r_ * lg0.z + lb0.z, (bfhi(x.y) - m_) * r_ * lg0.w + lb0.w);
                  p.z = cvtpk((bflo(x.z) - m_) * r_ * lg1.x + lb1.x, (bfhi(x.z) - m_) * r_ * lg1.y + lb1.y); p.w = cvtpk((bflo(x.w) - m_) * r_ * lg1.z + lb1.z, (bfhi(x.w) - m_) * r_ * lg1.w + lb1.w);
                  *(LAS v4u*)(im + j * 272 + ch * 16) = p; } }
            if (gi < 3) { SGU_LOAD_V(g + 1); SGU_LOAD_LN(g + 1); }
            __syncthreads();
            const LAS unsigned char* tb = trb + (gi & 1) * SGU_IMG_BYTES;
            f32x16 acc0, acc1;
#pragma unroll
            for (int r = 0; r < 16; ++r) { acc0[r] = 0.f; acc1[r] = 0.f; }
#pragma unroll
            for (int s = 0; s < 8; ++s) { const s16x4 lo_ = tr16(tb + (16 * s) * 272), hi_ = tr16(tb + (16 * s + 4) * 272);
                const bf16x8 af = (bf16x8){lo_[0], lo_[1], lo_[2], lo_[3], hi_[0], hi_[1], hi_[2], hi_[3]};
                acc0 = MFMA32(af, __builtin_bit_cast(bf16x8, bw[0][s]), acc0); acc1 = MFMA32(af, __builtin_bit_cast(bf16x8, bw[1][s]), acc1); }
            if (gi < 3) SGU_LOAD_W(g + 1);
#pragma unroll
            for (int it = 0; it < 2; ++it) { const int i = 64 * ih + 32 * it + c; const float bias = bias2[it];
                bf16* sp = S + (size_t)(r0 + i) * SGW + g * GD + 32 * dblk + 4 * hh;
#pragma unroll
                for (int jj = 0; jj < 4; ++jj) { const v2u u2 = uw[it][jj];
                    const float m0 = (it == 0 ? acc0[4 * jj] : acc1[4 * jj]) + bias, m1 = (it == 0 ? acc0[4 * jj + 1] : acc1[4 * jj + 1]) + bias, m2 = (it == 0 ? acc0[4 * jj + 2] : acc1[4 * jj + 2]) + bias, m3 = (it == 0 ? acc0[4 * jj + 3] : acc1[4 * jj + 3]) + bias;
                    v2u o; o.x = cvtpk(bflo(u2.x) * m0, bfhi(u2.x) * m1); o.y = cvtpk(bflo(u2.y) * m2, bfhi(u2.y) * m3); *(GAS v2u*)(sp + 8 * jj) = o; } }
        }
#undef SGU_LOAD_V
#undef SGU_LOAD_W
#undef SGU_LOAD_LN
    }
    __syncthreads();
}

constexpr int N_PHASES = 1 + 6 * DEPTH;
#ifndef MIX_IMPL
#define MIX_IMPL 2
#endif
#ifndef PROBE_DUP
#define PROBE_DUP -1
#endif
#ifndef MK_PER_PHASE
#define MK_PER_PHASE 0
#endif


#ifndef STAGGER_SLEEP
#define STAGGER_SLEEP 0
#endif
__device__ __forceinline__ void phase_stagger() {
    if (STAGGER_SLEEP > 0) { const int g = __builtin_amdgcn_readfirstlane((int)((blockIdx.x >> 3) & 3u)); for (int i = 0; i < g; ++i) __builtin_amdgcn_s_sleep(STAGGER_SLEEP); }
}


#ifndef GEMM_KROT
#define GEMM_KROT 1
#endif
#define KROT(K) (GEMM_KROT ? (int)(blockIdx.x % 8u) * ((K) / 64 / 8) : 0)
#ifndef INPROJ_SPLIT
#define INPROJ_SPLIT 0
#endif
#ifndef CONV_IN_MIX
#define CONV_IN_MIX 1
#endif
template <bool ON, int L, int BASE> struct SideSel { typedef ConvSide<L, BASE> T; };
template <int L, int BASE> struct SideSel<false, L, BASE> { typedef pg8::NoSide T; };
constexpr int RS_TAB_OFF = RING_BYTES;
template <class Sched> __device__ __forceinline__ int build_rs_tab(Frame& F, const Sched& S, const unsigned long long* rowsq) {
    pg8::Unit u0; int pm = -1; if (S.next(0, u0)) pm = u0.pm;
    for (int i = 1; S.next(i, u0); ++i) if (u0.pm != pm) pm = -2;
    __syncthreads();
    if (pm >= 0 && F.tid < 256) ((LAS float*)(F.lds + RS_TAB_OFF))[F.tid] = pg8::rs_of(rowsq[(size_t)pm * 256 + F.tid]);
    __syncthreads();
    return pm;
}

constexpr int SW_TAB_OFF = RS_TAB_OFF + 1024, SW_TAB_UNITS = 9;
template <class Sched> __device__ __forceinline__ void build_sw_tab(Frame& F, const Sched& S, const float* sw, int pn_off) {
    pg8::Unit u_;
    for (int i = 0; i < SW_TAB_UNITS && S.next(i, u_); ++i)
        if (F.tid < 256) ((LAS float*)(F.lds + SW_TAB_OFF))[i * 256 + F.tid] = sw[(size_t)(u_.pn + pn_off) * 256 + F.tid];
}

constexpr bool NEED_XB = !(I8_INPROJ && I8_FF1);
constexpr int CW_PANEL = 786432;
template <class Sched> __device__ __forceinline__ void panel_group(Frame& F, const Sched& S, int pmt, int& rank, int& n) {
    volatile LAS int* sc = (volatile LAS int*)(F.lds + RS_TAB_OFF);
    bool same = false;
    if (F.tid < F.G) { Sched S2 = S; S2.c = F.tid; pg8::Unit u_; same = S2.next(0, u_) && u_.pm == pmt; }
    const unsigned long long b0 = __ballot(same), b1 = __ballot(same && F.tid < S.c);
    if (F.lane == 0) { sc[F.wave] = __popcll(b0); sc[NWAVES + F.wave] = __popcll(b1); }
    __syncthreads();
    int nn = 0, rr = 0;
#pragma unroll
    for (int w = 0; w < NWAVES; ++w) { nn += sc[w]; rr += sc[NWAVES + w]; }
    n = __builtin_amdgcn_readfirstlane(nn); rank = __builtin_amdgcn_readfirstlane(rr);
    if (F.G > NWAVES * 64 || pmt < 0 || (n != 1 && n != 2 && n != 4 && n != 8)) { n = 1; rank = 0; }
    __syncthreads();
}
__device__ __forceinline__ void panel_barrier(unsigned* cnt, unsigned n, unsigned* bar) {
    asm volatile("s_waitcnt vmcnt(0)" ::: "memory");
    __syncthreads();
    if (threadIdx.x == 0) {
        __builtin_amdgcn_fence(__ATOMIC_RELEASE, "agent");
        asm volatile("s_waitcnt vmcnt(0)" ::: "memory");
        (void)xb_add(cnt, 1u);
        XB_SPIN(xb_ld(cnt) < n, bar);
        __builtin_amdgcn_fence(__ATOMIC_ACQUIRE, "agent");
        asm volatile("s_waitcnt vmcnt(0)" ::: "memory");
    }
    __syncthreads();
}
template <class Sched> __device__ __forceinline__ void quant_coop(Frame& F, const Sched& S, int pmt, const bf16* XBp, const float* Xf, const bf16* Yp, signed char* X8p, float* sxp, const unsigned long long* rowsq_p, unsigned* cnt, unsigned* bar,
                                                      const float* Xf2 = nullptr, const bf16* Yp2 = nullptr, signed char* X8p2 = nullptr, float* sxp2 = nullptr) {
    int rank, n; panel_group(F, S, pmt, rank, n);
    if (pmt >= 0) {
        const int per = 256 / n, nr = per / NWAVES, row0 = rank * per + F.wave * nr;
        if (Xf && Yp) quant_panel_f32<true>(F, Xf, Yp, X8p, sxp, row0, nr); else if (Xf) quant_panel_f32<false>(F, Xf, nullptr, X8p, sxp, row0, nr); else quant_panel_i8(F, XBp, X8p, sxp, rowsq_p, row0, nr);
        if (Xf2) quant_panel_f32<true>(F, Xf2, Yp2, X8p2, sxp2, row0, nr);
        panel_barrier(cnt, (unsigned)n, bar);
        if (F.tid < 256) ((LAS float*)(F.lds + RS_TAB_OFF))[F.tid] = sxp[F.tid];
    }
    asm volatile("s_waitcnt vmcnt(0) lgkmcnt(0)" ::: "memory"); __syncthreads();
}
__device__ __forceinline__ void tab_from_sx(Frame& F, const float* sxp) {
    __syncthreads();
    if (F.tid < 256) ((LAS float*)(F.lds + RS_TAB_OFF))[F.tid] = sxp[F.tid];
    asm volatile("s_waitcnt vmcnt(0) lgkmcnt(0)" ::: "memory"); __syncthreads();
}
#ifndef DEFER_RES
#define DEFER_RES 1
#endif
#ifndef QUANT_BOTH
#define QUANT_BOTH 1
#endif
#ifndef DATAFLOW
#define DATAFLOW 1
#endif
#define PCNT(k, P) ((unsigned*)(F.ctl + CW_PANEL) + ((l * 8 + (k)) * 64 + (P)) * 16)
#define IN(k) (lo <= (k) && (k) < hi)
#define SEAM(k) do { if (IN(k) && IN((k) + 1)) { xcd_barrier(bar); if (PROBE_DUP == 30) xcd_barrier(bar); } } while (0)
template <int l> __device__ __forceinline__ void run_layer(Frame& F, const Args& args, unsigned char* ws, const XcdBarrier& bar, const int lo, const int hi) {
    constexpr int CONV_L = (l + 1 < DEPTH) ? l + 1 : -1;
    bf16* XB = (bf16*)(ws + WS_XB); bf16* PROJ = (bf16*)(ws + WS_PROJ); bf16* HID = (bf16*)(ws + WS_PROJ); bf16* OS = (bf16*)(ws + WS_OS); float* T = (float*)(ws + WS_T); bf16* MG = (bf16*)(ws + WS_MG);
    unsigned long long* RS = (unsigned long long*)(ws + WS_RS);
    bf16* YB = (bf16*)(ws + WS_XB);
    static_assert(!QUANT_BOTH || DEFER_RES, "QUANT_BOTH needs DEFER_RES");
    static_assert(!DEFER_RES || (!NEED_XB && FFN_SPLIT && I8_FF1), "DEFER_RES needs the int8 in-projection and FFN-up paths");

        const int p = 1 + 6 * l;
        const bf16* Win = (const bf16*)(ws + WS_WIN) + (size_t)l * INC * D; const bf16* Woab = (const bf16*)(ws + WS_WOAB) + (size_t)l * 4096 * 1024; const bf16* Wout = (const bf16*)(ws + WS_WOUT) + (size_t)l * D * D;
        const bf16* W1 = (const bf16*)(ws + WS_W1) + (size_t)l * DFF * D; const bf16* W2 = (const bf16*)(ws + WS_W2) + (size_t)l * D * DFF; const bf16* Wsp = (const bf16*)(ws + WS_WSP) + (size_t)l * NG * SL * SL;
#if I8_INPROJ
#define INPROJ_GEMM(PN0, NT) do { \
            pg8::Gemm g{(const bf16*)(ws + WS_XB8), (const bf16*)(ws + WS_WIN8 + (size_t)l * INC * D + (size_t)(PN0) * 256 * D), M, (NT) * 256, D / 2, KROT(D / 2)}; pg8::StaticOrder S; S.init(M, (NT) * 256, F.G, (int)blockIdx.x); \
            pg8::Unit u0_; const int pmt = S.next(0, u0_) ? u0_.pm : -1;     \
            __syncthreads(); \
            build_sw_tab(F, S, (const float*)(ws + WS_SWIN) + l * INC, (PN0)); \
            quant_coop(F, S, pmt, XB + (size_t)pmt * 256 * D, l == 0 ? args.in[0] + (size_t)pmt * 256 * D : (NEED_XB ? (const float*)nullptr : (const float*)args.out + (size_t)pmt * 256 * D), (const bf16*)nullptr, (signed char*)(ws + WS_XB8) + (size_t)pmt * 256 * D, (float*)(ws + WS_SX) + pmt * 256, RS + (size_t)(2 * l) * M + pmt * 256, \
                       PCNT(0, pmt), bar.bar); \
            typedef pg8::NoSide SideT; \
            pg8::EpiIn<true, SideT, true> E{PROJ, RS + (size_t)(2 * l) * M, INC, (const LAS float*)(F.lds + RS_TAB_OFF), pmt, SideT{}, (PN0), (const LAS float*)(F.lds + SW_TAB_OFF), ws + WS_G8}; \
            pg8::gemm_phase<pg8::EpiIn<true, SideT, true>, pg8::StaticOrder, GP_ALIGN, GP_SP2, 1>(F.lds + RING_OFF, g, S, E); } while (0)
#else
#define INPROJ_GEMM(PN0, NT) do { \
            pg8::Gemm g{XB, Win + (size_t)(PN0) * 256 * D, M, (NT) * 256, D, KROT(D)}; pg8::StaticOrder S; S.init(M, (NT) * 256, F.G, (int)blockIdx.x); \
            const int pmt = build_rs_tab(F, S, RS + (size_t)(2 * l) * M); \
            typedef pg8::NoSide SideT; \
            pg8::EpiIn<true, SideT> E{PROJ, RS + (size_t)(2 * l) * M, INC, (const LAS float*)(F.lds + RS_TAB_OFF), pmt, SideT{}, (PN0), nullptr}; pg8::EpiIn<false, SideT> EG{PROJ, RS + (size_t)(2 * l) * M, INC, nullptr, pmt, SideT{}, (PN0), nullptr}; \
            if (pmt >= 0) pg8::gemm_phase<pg8::EpiIn<true, SideT>, pg8::StaticOrder, GP_ALIGN, GP_SP2>(F.lds + RING_OFF, g, S, E); \
            else if (pmt == -2) pg8::gemm_phase<pg8::EpiIn<false, SideT>, pg8::StaticOrder, GP_ALIGN, GP_SP2>(F.lds + RING_OFF, g, S, EG); } while (0)
#endif
        if (IN(p)) {
            if (INPROJ_SPLIT) INPROJ_GEMM(0, 20); else INPROJ_GEMM(0, 36);
            if (PROBE_DUP == 11 || PROBE_DUP == 13) { pg8::Gemm g{XB, Win, M, INC, D, KROT(D)}; pg8::StaticOrder S; S.init(M, INC, F.G, (int)blockIdx.x); pg8::EpiNull EN{args.out};
                if (PROBE_DUP == 11) pg8::gemm_phase<pg8::EpiNull, pg8::StaticOrder, GP_ALIGN, GP_SP2, 0>(F.lds + RING_OFF, g, S, EN); else pg8::gemm_phase<pg8::EpiNull, pg8::StaticOrder, GP_ALIGN, GP_SP2, 1>(F.lds + RING_OFF, g, S, EN); }
            SEAM(p);
        }
        if (IN(p + 1)) {
#if MIX_IMPL >= 1
            attn_mfma(F, PROJ, OS, args.in[3] + l * SBW, args.in[4] + l * SBW, args, ws, CONV_IN_MIX ? l : -1);
#else
            attn_naive(F, PROJ, OS, args.in[3] + l * SBW, args.in[4] + l * SBW);
#endif
#if MIX_IMPL >= 2
            sgu_mfma(F, PROJ, OS + (size_t)M * SBW, Wsp, args.in[5] + l * SGW, args.in[6] + l * SGW, args.in[8] + l * NG * SL);
#else
            sgu_naive(F, PROJ, OS + (size_t)M * SBW, Wsp, args.in[5] + l * SGW, args.in[6] + l * SGW, args.in[8] + l * NG * SL);
#endif
            if (PROBE_DUP == 2 || PROBE_DUP == 21) attn_mfma(F, PROJ, OS, args.in[3] + l * SBW, args.in[4] + l * SBW, args, ws, CONV_IN_MIX ? l : -1);
            if (PROBE_DUP == 2 || PROBE_DUP == 22) sgu_mfma(F, PROJ, OS + (size_t)M * SBW, Wsp, args.in[5] + l * SGW, args.in[6] + l * SGW, args.in[8] + l * NG * SL);
            if (INPROJ_SPLIT) INPROJ_GEMM(20, 16);
            SEAM(p + 1);
        }
        if (IN(p + 2)) {
            phase_stagger();
            pg8::Gemm g{OS, Woab, 2 * M, 4096, 1024, KROT(1024)}; pg8::YabOrder S; S.init(M, D, F.G, (int)blockIdx.x);
            pg8::EpiYab E{PROJ, MG, INC, C_GA, C_GB, D, M / 256, D / 256, ws + WS_G8};
            pg8::gemm_phase<pg8::EpiYab, pg8::YabOrder, GP_ALIGN, GP_SP2>(F.lds + RING_OFF, g, S, E);
            if (PROBE_DUP == 3) pg8::gemm_phase<pg8::EpiYab, pg8::YabOrder, GP_ALIGN, GP_SP2>(F.lds + RING_OFF, g, S, E);
            if (IN(p + 2) && IN(p + 3)) { pg8::Unit u0_; S.next(0, u0_); if (DATAFLOW && F.G == 256) panel_barrier(PCNT(3, u0_.pm), (unsigned)(F.G / (M / 256)), bar.bar); else xcd_barrier(bar); }
        }
        if (IN(p + 3)) {
#if I8_OUT
            pg8::Gemm g{(const bf16*)(ws + WS_XB8), (const bf16*)(ws + WS_WOUT8 + (size_t)l * D * D), M, D, D / 2, KROT(D / 2)}; pg8::StaticOrder S; S.init(M, D, F.G, (int)blockIdx.x);
            pg8::Unit u0_; const int pmt = S.next(0, u0_) ? u0_.pm : -1;
            __syncthreads();
            build_sw_tab(F, S, (const float*)(ws + WS_SWOUT) + l * D, 0);
            quant_coop(F, S, pmt, MG + (size_t)pmt * 256 * D, (const float*)nullptr, (const bf16*)nullptr, (signed char*)(ws + WS_XB8) + (size_t)pmt * 256 * D, (float*)(ws + WS_SX) + pmt * 256, (const unsigned long long*)nullptr, PCNT(6, pmt), bar.bar);
            pg8::EpiBf8 E{YB, D, (const LAS float*)(F.lds + RS_TAB_OFF), (const LAS float*)(F.lds + SW_TAB_OFF)};
            pg8::gemm_phase<pg8::EpiBf8, pg8::StaticOrder, GP_ALIGN, GP_SP2, 1>(F.lds + RING_OFF, g, S, E);
#else
            pg8::Gemm g{MG, Wout, M, D, D, KROT(D)}; pg8::StaticOrder S; S.init(M, D, F.G, (int)blockIdx.x);
#if DEFER_RES
            pg8::EpiBf E{YB, D};
            pg8::gemm_phase<pg8::EpiBf, pg8::StaticOrder, GP_ALIGN, GP_SP2>(F.lds + RING_OFF, g, S, E);
#else
            pg8::EpiRes<false, NEED_XB> E{l == 0 ? args.in[0] : (const float*)args.out, args.out, XB, RS + (size_t)(2 * l + 1) * M, D, nullptr, nullptr};
            pg8::gemm_phase<pg8::EpiRes<false, NEED_XB>, pg8::StaticOrder, GP_ALIGN, GP_SP2>(F.lds + RING_OFF, g, S, E);
#endif
#endif
            SEAM(p + 3);
        }
#if FFN_SPLIT
        if (IN(p + 4)) {
            { constexpr int hf = 0;
                const size_t r0 = (size_t)hf * (M / 2);
                int pmf = 0;
#if I8_FF1
                { pg8::Gemm g{(const bf16*)(ws + WS_XB8 + r0 * D), (const bf16*)(ws + WS_W18 + (size_t)l * DFF * D), M / 2, DFF, D / 2, KROT(D / 2)}; pg8::StaticOrder S; S.init(M / 2, DFF, F.G, (int)blockIdx.x);
                  pg8::Unit u0_; const int pmt = S.next(0, u0_) ? u0_.pm : -1; pmf = pmt;
                  __syncthreads();
                  build_sw_tab(F, S, (const float*)(ws + WS_SW1) + l * DFF, 0);
#if QUANT_BOTH
                  { const size_t r1 = (size_t)(M / 2) + (size_t)pmt * 256;
                  quant_coop(F, S, pmt, XB + (r0 + (size_t)pmt * 256) * D, (DEFER_RES && l == 0 ? args.in[0] : (const float*)args.out) + (r0 + (size_t)pmt * 256) * D, YB + (r0 + (size_t)pmt * 256) * D, (signed char*)(ws + WS_XB8) + (r0 + (size_t)pmt * 256) * D, (float*)(ws + WS_SX) + r0 + pmt * 256, RS + (size_t)(2 * l + 1) * M + r0 + pmt * 256,
                             PCNT(1 + hf, pmt), bar.bar, (DEFER_RES && l == 0 ? args.in[0] : (const float*)args.out) + r1 * D, YB + r1 * D, (signed char*)(ws + WS_XB8) + r1 * D, (float*)(ws + WS_SX) + r1); }
#else
                  quant_coop(F, S, pmt, XB + (r0 + (size_t)pmt * 256) * D, NEED_XB ? (const float*)nullptr : (DEFER_RES && l == 0 ? args.in[0] : (const float*)args.out) + (r0 + (size_t)pmt * 256) * D, DEFER_RES ? YB + (r0 + (size_t)pmt * 256) * D : (const bf16*)nullptr, (signed char*)(ws + WS_XB8) + (r0 + (size_t)pmt * 256) * D, (float*)(ws + WS_SX) + r0 + pmt * 256, RS + (size_t)(2 * l + 1) * M + r0 + pmt * 256,
                             PCNT(1 + hf, pmt), bar.bar);
#endif
                  pg8::EpiFF1<true, pg8::NoSide, true> E8{HID + r0 * DFF, RS + (size_t)(2 * l + 1) * M + r0, DFF, (const LAS float*)(F.lds + RS_TAB_OFF), pmt, pg8::NoSide{}, (const LAS float*)(F.lds + SW_TAB_OFF)};
                  pg8::gemm_phase<pg8::EpiFF1<true, pg8::NoSide, true>, pg8::StaticOrder, GP_ALIGN, GP_SP2, 1>(F.lds + RING_OFF, g, S, E8); }
#else
                { pg8::Gemm g{XB + r0 * D, W1, M / 2, DFF, D, KROT(D)}; pg8::StaticOrder S; S.init(M / 2, DFF, F.G, (int)blockIdx.x);
                  const int pmt = build_rs_tab(F, S, RS + (size_t)(2 * l + 1) * M + r0);
                  typedef typename SideSel<(CONV_L >= 0) && !CONV_IN_MIX, (CONV_L >= 0 ? CONV_L : 0), 9 + 4 * hf>::T SideT; const SideT side{};
                  pg8::EpiFF1<true, SideT> E{HID + r0 * DFF, RS + (size_t)(2 * l + 1) * M + r0, DFF, (const LAS float*)(F.lds + RS_TAB_OFF), pmt, side, nullptr}; pg8::EpiFF1<false, SideT> EG{HID + r0 * DFF, RS + (size_t)(2 * l + 1) * M + r0, DFF, nullptr, pmt, side, nullptr};
                  if (pmt >= 0) pg8::gemm_phase<pg8::EpiFF1<true, SideT>, pg8::StaticOrder, GP_ALIGN, GP_SP2>(F.lds + RING_OFF, g, S, E);
                  else if (pmt == -2) pg8::gemm_phase<pg8::EpiFF1<false, SideT>, pg8::StaticOrder, GP_ALIGN, GP_SP2>(F.lds + RING_OFF, g, S, EG); }
#endif
                if (DATAFLOW && I8_FF1 && F.G == 256) panel_barrier(PCNT(4 + hf, pmf), (unsigned)(F.G / (M / 2 / 256)), bar.bar); else xcd_barrier(bar);
                { pg8::Gemm g{HID + r0 * DFF, W2, M / 2, D, DFF, KROT(DFF)}; pg8::StaticOrder S; S.init(M / 2, D, F.G, (int)blockIdx.x);
                  pg8::EpiRes<false, NEED_XB, DEFER_RES> E{(DEFER_RES && l == 0 ? args.in[0] : (const float*)args.out) + r0 * D, args.out + r0 * D, XB + r0 * D, l + 1 < DEPTH ? RS + (size_t)(2 * l + 2) * M + r0 : nullptr, D, nullptr, nullptr, DEFER_RES ? YB + r0 * D : (const bf16*)nullptr};
                  pg8::gemm_phase<pg8::EpiRes<false, NEED_XB, DEFER_RES>, pg8::StaticOrder, GP_ALIGN, GP_SP2>(F.lds + RING_OFF, g, S, E); }
            }
            { constexpr int hf = 1;
                const size_t r0 = (size_t)hf * (M / 2);
                int pmf = 0;
#if I8_FF1
                { pg8::Gemm g{(const bf16*)(ws + WS_XB8 + r0 * D), (const bf16*)(ws + WS_W18 + (size_t)l * DFF * D), M / 2, DFF, D / 2, KROT(D / 2)}; pg8::StaticOrder S; S.init(M / 2, DFF, F.G, (int)blockIdx.x);
                  pg8::Unit u0_; const int pmt = S.next(0, u0_) ? u0_.pm : -1; pmf = pmt;
                  __syncthreads();
                  build_sw_tab(F, S, (const float*)(ws + WS_SW1) + l * DFF, 0);
#if QUANT_BOTH
                  tab_from_sx(F, (const float*)(ws + WS_SX) + r0 + pmt * 256);
#else
                  quant_coop(F, S, pmt, XB + (r0 + (size_t)pmt * 256) * D, NEED_XB ? (const float*)nullptr : (DEFER_RES && l == 0 ? args.in[0] : (const float*)args.out) + (r0 + (size_t)pmt * 256) * D, DEFER_RES ? YB + (r0 + (size_t)pmt * 256) * D : (const bf16*)nullptr, (signed char*)(ws + WS_XB8) + (r0 + (size_t)pmt * 256) * D, (float*)(ws + WS_SX) + r0 + pmt * 256, RS + (size_t)(2 * l + 1) * M + r0 + pmt * 256,
                             PCNT(1 + hf, pmt), bar.bar);
#endif
                  pg8::EpiFF1<true, pg8::NoSide, true> E8{HID + r0 * DFF, RS + (size_t)(2 * l + 1) * M + r0, DFF, (const LAS float*)(F.lds + RS_TAB_OFF), pmt, pg8::NoSide{}, (const LAS float*)(F.lds + SW_TAB_OFF)};
                  pg8::gemm_phase<pg8::EpiFF1<true, pg8::NoSide, true>, pg8::StaticOrder, GP_ALIGN, GP_SP2, 1>(F.lds + RING_OFF, g, S, E8); }
#else
                { pg8::Gemm g{XB + r0 * D, W1, M / 2, DFF, D, KROT(D)}; pg8::StaticOrder S; S.init(M / 2, DFF, F.G, (int)blockIdx.x);
                  const int pmt = build_rs_tab(F, S, RS + (size_t)(2 * l + 1) * M + r0);
                  typedef typename SideSel<(CONV_L >= 0) && !CONV_IN_MIX, (CONV_L >= 0 ? CONV_L : 0), 9 + 4 * hf>::T SideT; const SideT side{};
                  pg8::EpiFF1<true, SideT> E{HID + r0 * DFF, RS + (size_t)(2 * l + 1) * M + r0, DFF, (const LAS float*)(F.lds + RS_TAB_OFF), pmt, side, nullptr}; pg8::EpiFF1<false, SideT> EG{HID + r0 * DFF, RS + (size_t)(2 * l + 1) * M + r0, DFF, nullptr, pmt, side, nullptr};
                  if (pmt >= 0) pg8::gemm_phase<pg8::EpiFF1<true, SideT>, pg8::StaticOrder, GP_ALIGN, GP_SP2>(F.lds + RING_OFF, g, S, E);
                  else if (pmt == -2) pg8::gemm_phase<pg8::EpiFF1<false, SideT>, pg8::StaticOrder, GP_ALIGN, GP_SP2>(F.lds + RING_OFF, g, S, EG); }
#endif
                if (DATAFLOW && I8_FF1 && F.G == 256) panel_barrier(PCNT(4 + hf, pmf), (unsigned)(F.G / (M / 2 / 256)), bar.bar); else xcd_barrier(bar);
                { pg8::Gemm g{HID + r0 * DFF, W2, M / 2, D, DFF, KROT(DFF)}; pg8::StaticOrder S; S.init(M / 2, D, F.G, (int)blockIdx.x);
                  pg8::EpiRes<false, NEED_XB, DEFER_RES> E{(DEFER_RES && l == 0 ? args.in[0] : (const float*)args.out) + r0 * D, args.out + r0 * D, XB + r0 * D, l + 1 < DEPTH ? RS + (size_t)(2 * l + 2) * M + r0 : nullptr, D, nullptr, nullptr, DEFER_RES ? YB + r0 * D : (const bf16*)nullptr};
                  pg8::gemm_phase<pg8::EpiRes<false, NEED_XB, DEFER_RES>, pg8::StaticOrder, GP_ALIGN, GP_SP2>(F.lds + RING_OFF, g, S, E); }
            }
            SEAM(p + 5);
        }
#else
        if (IN(p + 4)) {
            phase_stagger();
            pg8::Gemm g{XB, W1, M, DFF, D, KROT(D)}; pg8::StaticOrder S; S.init(M, DFF, F.G, (int)blockIdx.x);
            const int pmt = build_rs_tab(F, S, RS + (size_t)(2 * l + 1) * M);
            pg8::EpiFF1<true> E{HID, RS + (size_t)(2 * l + 1) * M, DFF, (const LAS float*)(F.lds + RS_TAB_OFF), pmt, pg8::NoSide{}, nullptr}; pg8::EpiFF1<false> EG{HID, RS + (size_t)(2 * l + 1) * M, DFF, nullptr, pmt, pg8::NoSide{}, nullptr};
            if (pmt >= 0) pg8::gemm_phase<pg8::EpiFF1<true>, pg8::StaticOrder, GP_ALIGN, GP_SP2>(F.lds + RING_OFF, g, S, E);
            else if (pmt == -2) pg8::gemm_phase<pg8::EpiFF1<false>, pg8::StaticOrder, GP_ALIGN, GP_SP2>(F.lds + RING_OFF, g, S, EG);
            SEAM(p + 4);
        }
        if (IN(p + 5)) {
            phase_stagger();
            pg8::Gemm g{HID, W2, M, D, DFF, KROT(DFF)}; pg8::StaticOrder S; S.init(M, D, F.G, (int)blockIdx.x);
            pg8::EpiRes<false> E{(const float*)args.out, args.out, XB, l + 1 < DEPTH ? RS + (size_t)(2 * l + 2) * M : nullptr, D, nullptr, nullptr};
            if (PROBE_DUP == 6) { pg8::EpiNull EN{args.out}; pg8::gemm_phase<pg8::EpiNull, pg8::StaticOrder, GP_ALIGN, GP_SP2>(F.lds + RING_OFF, g, S, EN); }
            pg8::gemm_phase<pg8::EpiRes<false>, pg8::StaticOrder, GP_ALIGN, GP_SP2>(F.lds + RING_OFF, g, S, E);
            SEAM(p + 5);
        }
#endif
    }
__global__ void __launch_bounds__(NWAVES * 64, 2) mk_fwd(Args args) {
    extern __shared__ __attribute__((aligned(16))) unsigned char lds[];
    Frame F;
    F.lds = (LAS unsigned char*)lds;
    F.MISC = (volatile LAS unsigned*)(F.lds + MISC_OFF);
    F.tid = threadIdx.x; F.lane = F.tid & 63; F.wave = __builtin_amdgcn_readfirstlane(F.tid >> 6);
    F.G = gridDim.x; { const int bx = blockIdx.x; F.vcu = (F.G % 8 == 0) ? (bx % 8) * (F.G / 8) + bx / 8 : bx; }
    unsigned char* ws = args.ws;
    F.ctl = (gu32*)(ws + WS_CTL);
    for (int u = F.tid; u < (LDS_BYTES - LDSCTL_OFF) / 4; u += NWAVES * 64) ((LAS unsigned*)(F.lds + LDSCTL_OFF))[u] = 0u;
    __syncthreads();
    XcdBarrier bar; bar.bar = (unsigned*)(F.ctl + CW_BAR); bar.x = 0; bar.st = nullptr;
    if (!MK_PER_PHASE) bar = xcd_barrier_post((unsigned*)(F.ctl + CW_BAR), F.MISC + 8);
    const int lo = args.ph_lo, hi = args.ph_hi;

    if (IN(0)) { p0_prologue(F, args, ws); if (PROBE_DUP == 0) { __syncthreads(); p0_prologue(F, args, ws); } SEAM(0); }

    run_layer<0>(F, args, ws, bar, lo, hi); run_layer<1>(F, args, ws, bar, lo, hi); run_layer<2>(F, args, ws, bar, lo, hi); run_layer<3>(F, args, ws, bar, lo, hi);
#undef IN
#undef SEAM
}

extern "C" void kernel_launch(void* const* d_in, const int* in_sizes, int n_in, void* d_out, int out_size, void* d_ws, size_t ws_size, hipStream_t stream) {
    static int grid = 0;
    if (grid == 0) {
        if (n_in != 15 || in_sizes[0] != M * D || out_size != M * D || ws_size < WS_END) { fprintf(stderr, "kernel_launch: shape/workspace mismatch: n_in %d in0 %d out %d ws %zu (need %zu); nothing launched\n", n_in, n_in > 0 ? in_sizes[0] : -1, out_size, ws_size, (size_t)WS_END); grid = -1; return; }
        int dev = 0, cus = 0, per_cu = 0;
        if (hipGetDevice(&dev) != hipSuccess || hipDeviceGetAttribute(&cus, hipDeviceAttributeMultiprocessorCount, dev) != hipSuccess) { fprintf(stderr, "kernel_launch: device query failed\n"); grid = -1; return; }
        if (hipFuncSetAttribute((const void*)mk_fwd, hipFuncAttributeMaxDynamicSharedMemorySize, LDS_BYTES) != hipSuccess) { fprintf(stderr, "kernel_launch: hipFuncSetAttribute failed\n"); grid = -1; return; }
        if (hipOccupancyMaxActiveBlocksPerMultiprocessor(&per_cu, (const void*)mk_fwd, NWAVES * 64, LDS_BYTES) != hipSuccess || per_cu < 1)
            fprintf(stderr, "kernel_launch: note: occupancy query reports %d workgroups per CU\n", per_cu);
        (void)hipGetLastError();
        grid = cus;
    }
    if (grid < 0) return;
    if (hipMemsetAsync((char*)d_ws + WS_CTL, 0, CTL_ZERO_BYTES, stream) != hipSuccess) { fprintf(stderr, "kernel_launch: memset failed\n"); return; }
    Args a{};
    for (int i = 0; i < 15; ++i) a.in[i] = (const float*)d_in[i];
    a.out = (float*)d_out; a.ws = (unsigned char*)d_ws;
#if MK_PER_PHASE
    for (int ph = 0; ph < N_PHASES; ++ph) { a.ph_lo = ph; a.ph_hi = ph + 1; hipLaunchKernelGGL(mk_fwd, dim3(grid), dim3(NWAVES * 64), LDS_BYTES, stream, a); }
#else
    a.ph_lo = 0; a.ph_hi = N_PHASES;
    hipLaunchKernelGGL(mk_fwd, dim3(grid), dim3(NWAVES * 64), LDS_BYTES, stream, a);
#endif
    const hipError_t le = hipPeekAtLastError();
    if (le != hipSuccess) fprintf(stderr, "kernel_launch: launch failed: %s\n", hipGetErrorName(le));
}
```
